# Optimizing an MI355X kernel written in HIP

```python
import functools
import jax, jax.numpy as jnp
from jax import lax
import numpy as np

D_MODEL = 4096
BATCH = 1
SEQ = 8192
DEPTH = 1
DEC_BATCH = 32
DEC_SEQ = 8
PAST_LEN = 8192
PAGE_SIZE = 128

DIL_GROUPS = ((128, 1), (512, 4), (2048, 16))
N_GROUPS = 3
A_HEADS = D_MODEL // 512
HEAD_DIM = 128
A_WIDTH = A_HEADS * HEAD_DIM
BAND_BLOCK = 128
HG_HEADS = D_MODEL // 256
HG_KDIM = 128
HG_VDIM = 128
HG_FDIM = HG_HEADS * HG_KDIM
HG_WIDTH = HG_HEADS * HG_VDIM
HG_CHUNK = 32
FFN_HIDDEN = 4 * D_MODEL
PLE_DIM = 256
IN_SIZES = (N_GROUPS * A_WIDTH, N_GROUPS * A_WIDTH, N_GROUPS * A_WIDTH, HG_FDIM, HG_FDIM, HG_WIDTH, HG_WIDTH, D_MODEL, D_MODEL)
IN_WIDTH = sum(IN_SIZES)
NORM_EPS = 1e-6

kernel_name = 'hybrid_dilated_attn_hgrn2_decoder_step'


def rms_norm(x, g):
    xf = x.astype(jnp.float32)
    y = xf * lax.rsqrt(jnp.mean(xf * xf, axis=-1, keepdims=True) + NORM_EPS)
    return (y * g.astype(jnp.float32)).astype(x.dtype)


def _alibi_slopes():
    n = N_GROUPS * A_HEADS
    e = jnp.arange(1, n + 1, dtype=jnp.float32)
    return jnp.exp2(-8.0 * e / n).reshape(N_GROUPS, A_HEADS)


def _split_cols(z):
    out, start = [], 0
    for s in IN_SIZES:
        out.append(z[..., start:start + s])
        start += s
    return out


def _band_dilated_attention(q, k, v, window, dil, slopes):
    B, S, H, D = q.shape
    nk = window // dil
    L = S // dil
    nb = -(-L // BAND_BLOCK)
    Lp = nb * BAND_BLOCK

    def split(a):
        a = a.reshape(B, L, dil, H, D).transpose(0, 2, 1, 3, 4)
        a = jnp.pad(a, ((0, 0), (0, 0), (0, Lp - L), (0, 0), (0, 0)))
        return a.reshape(B, dil, nb, BAND_BLOCK, H, D)

    def with_prev(a):
        prev = jnp.pad(a, ((0, 0), (0, 0), (1, 0), (0, 0), (0, 0), (0, 0)))[:, :, :-1]
        return jnp.concatenate([prev, a], axis=3)

    qb = split(q)
    kk, vv = with_prev(split(k)), with_prev(split(v))
    logits = jnp.einsum('bznihd,bznjhd->bznhij', qb, kk).astype(jnp.float32) * (HEAD_DIM ** -0.5)
    i = jnp.arange(BAND_BLOCK)[:, None]
    j = jnp.arange(2 * BAND_BLOCK)[None, :]
    delta = BAND_BLOCK + i - j
    key_u = (jnp.arange(nb)[:, None, None] - 1) * BAND_BLOCK + j[None]
    valid = (delta >= 0)[None] & (delta <= nk)[None] & (key_u >= 0)
    bias = -slopes[:, None, None] * (delta * dil).astype(jnp.float32)[None]
    logits = jnp.where(valid[:, None], logits + bias, -jnp.inf)
    lse = jax.nn.logsumexp(logits, axis=-1)
    probs = jnp.exp(logits - lse[..., None])
    o = jnp.einsum('bznhij,bznjhd->bznihd', probs, vv.astype(jnp.float32))
    o = o.reshape(B, dil, Lp, H, D)[:, :, :L].transpose(0, 2, 1, 3, 4).reshape(B, S, H, D)
    lse = lse.transpose(0, 1, 2, 4, 3).reshape(B, dil, Lp, H)[:, :, :L].transpose(0, 2, 1, 3).reshape(B, S, H)
    return o, lse


def _merge_dilations(outs, lses, dtype):
    w = jax.nn.softmax(jnp.stack(lses, axis=0), axis=0)
    o = jnp.sum(w[..., None] * jnp.stack(outs, axis=0), axis=0)
    return o.reshape(o.shape[0], o.shape[1], A_WIDTH).astype(dtype)


def _attend_prompt(q, k, v, slopes):
    S = q.shape[1]
    outs, lses, rows = [], [], []
    for g, (window, dil) in enumerate(DIL_GROUPS):
        o, lse = _band_dilated_attention(q[:, :, g], k[:, :, g], v[:, :, g], window, dil, slopes[g])
        outs.append(o)
        lses.append(lse)
        L = min(window, S)
        rows.append(jnp.stack([k[:, S - L:, g], v[:, S - L:, g]], axis=2))
    return _merge_dilations(outs, lses, q.dtype), rows


def _attend_sample(q, k, v, caches, slopes):
    T = q.shape[1]
    outs, lses, rows = [], [], []
    for g, (window, dil) in enumerate(DIL_GROUPS):
        buf = caches[g]
        L = buf.shape[1]
        k_all = jnp.concatenate([buf[:, :, 0], k[:, :, g]], axis=1)
        v_all = jnp.concatenate([buf[:, :, 1], v[:, :, g]], axis=1)
        jj = jnp.arange(window // dil + 1)
        idx = (L + jnp.arange(T))[:, None] - dil * jj[None, :]
        valid = idx >= 0
        idx = jnp.maximum(idx, 0)
        ks, vs = k_all[:, idx], v_all[:, idx]
        logits = jnp.einsum('bthd,btjhd->bthj', q[:, :, g], ks).astype(jnp.float32) * (HEAD_DIM ** -0.5)
        bias = -slopes[g][:, None] * (dil * jj).astype(jnp.float32)[None, :]
        logits = jnp.where(valid[None, :, None, :], logits + bias, -jnp.inf)
        lse = jax.nn.logsumexp(logits, axis=-1)
        probs = jnp.exp(logits - lse[..., None])
        outs.append(jnp.einsum('bthj,btjhd->bthd', probs, vs.astype(jnp.float32)))
        lses.append(lse)
        rows.append(jnp.stack([k[:, :, g], v[:, :, g]], axis=2))
    return _merge_dilations(outs, lses, q.dtype), rows


def _gla_chunked(q, k, v, log_g, s0):
    B, T, H, K = q.shape
    V = v.shape[-1]
    n = -(-T // HG_CHUNK)
    pad = n * HG_CHUNK - T

    def prep(a):
        a = jnp.pad(a, ((0, 0), (0, pad), (0, 0), (0, 0)))
        return a.reshape(B, n, HG_CHUNK, H, a.shape[-1]).transpose(1, 0, 2, 3, 4)

    tri = jnp.tril(jnp.ones((HG_CHUNK, HG_CHUNK), dtype=bool))

    def step(S, inp):
        qc, kc, vc, gc = inp
        b = jnp.cumsum(gc, axis=1)
        q_dec = qc * jnp.exp(b)
        k_dec = kc * jnp.exp(-b)
        o = jnp.einsum('bchk,bhkv->bchv', q_dec, S)
        A = jnp.where(tri, jnp.einsum('bthk,bshk->bhts', q_dec, k_dec), 0.0)
        o = o + jnp.einsum('bhts,bshv->bthv', A, vc)
        b_last = b[:, -1]
        S = S * jnp.exp(b_last)[..., None] + jnp.einsum('bshk,bshv->bhkv', kc * jnp.exp(b_last[:, None] - b), vc)
        return S, o

    S, o = lax.scan(step, s0, (prep(q), prep(k), prep(v), prep(log_g)))
    o = o.transpose(1, 0, 2, 3, 4).reshape(B, n * HG_CHUNK, H, V)[:, :T]
    return o, S


def _hgrn2_branch(hq, hf, hi, hog, lb, g_out, s0):
    B, T, _ = hq.shape
    f32 = jnp.float32
    q = jax.nn.silu(hq.astype(f32)).reshape(B, T, HG_HEADS, HG_KDIM) * (HG_KDIM ** -0.5)
    f = hf.astype(f32)
    gate = lb + (1.0 - lb) * jax.nn.sigmoid(f)
    log_g = jnp.log(gate).reshape(B, T, HG_HEADS, HG_KDIM)
    k = ((1.0 - lb) * jax.nn.sigmoid(-f)).reshape(B, T, HG_HEADS, HG_KDIM)
    v = hi.astype(f32).reshape(B, T, HG_HEADS, HG_VDIM)
    o, s_new = _gla_chunked(q, k, v, log_g, s0.astype(f32))
    o = rms_norm(o, g_out) * jax.nn.sigmoid(hog.astype(f32).reshape(B, T, HG_HEADS, HG_VDIM))
    return o.reshape(B, T, HG_WIDTH).astype(hq.dtype), s_new.astype(s0.dtype)


def _layer(x, p, s0, attend, lb, g_mix, w_in, g_q, g_k, g_hg_out, w_up_attn, w_up_hgrn, w_out,
           g_ffn, w_ff_up, w_ff_down, w_ple, w_ple_gate):
    B, T, _ = x.shape
    n = rms_norm(x, g_mix)
    qa, ka, va, hq, hf, hi, hog, ga, gb = _split_cols(n @ w_in)
    qa = rms_norm(qa.reshape(B, T, N_GROUPS, A_HEADS, HEAD_DIM), g_q[:, None, :])
    ka = rms_norm(ka.reshape(B, T, N_GROUPS, A_HEADS, HEAD_DIM), g_k[:, None, :])
    va = va.reshape(B, T, N_GROUPS, A_HEADS, HEAD_DIM)
    o_attn, kv_rows = attend(qa, ka, va)
    o_hg, s_new = _hgrn2_branch(hq, hf, hi, hog, lb, g_hg_out, s0)
    merged = jax.nn.sigmoid(ga) * (o_attn @ w_up_attn) + jax.nn.sigmoid(gb) * (o_hg @ w_up_hgrn)
    x = x + merged @ w_out
    h = rms_norm(x, g_ffn)
    x = x + jnp.square(jax.nn.relu(h @ w_ff_up)) @ w_ff_down
    x = x + jax.nn.sigmoid(x @ w_ple_gate) * (p @ w_ple)
    return x, kv_rows, s_new


def setup_inputs(seed: int = 0) -> dict:
    key = jax.random.key(seed)
    ks = jax.random.split(key, 24)
    f32 = jnp.float32

    def nrm(k, shape, scale=1.0):
        return jax.random.normal(k, shape, f32) * scale

    def gain(k, shape):
        return 1.0 + 0.02 * jax.random.normal(k, shape, f32)

    buf_len = [min(w, PAST_LEN) for w, _ in DIL_GROUPS]
    return {
        'x_prompt': nrm(ks[0], (BATCH, SEQ, D_MODEL)),
        'x_sample': nrm(ks[1], (DEC_BATCH, DEC_SEQ, D_MODEL)),
        'cache_kv_w128': nrm(ks[2], (DEPTH, DEC_BATCH, buf_len[0], 2, A_HEADS, HEAD_DIM)),
        'cache_kv_w512': nrm(ks[3], (DEPTH, DEC_BATCH, buf_len[1], 2, A_HEADS, HEAD_DIM)),
        'cache_kv_w2048': nrm(ks[4], (DEPTH, DEC_BATCH, buf_len[2], 2, A_HEADS, HEAD_DIM)),
        'state_hgrn': nrm(ks[5], (DEPTH, DEC_BATCH, HG_HEADS, HG_KDIM, HG_VDIM), 0.5),
        'p_prompt': nrm(ks[6], (DEPTH, BATCH, SEQ, PLE_DIM)),
        'p_sample': nrm(ks[7], (DEPTH, DEC_BATCH, DEC_SEQ, PLE_DIM)),
        'g_mix': gain(ks[8], (DEPTH, D_MODEL)),
        'w_in': nrm(ks[9], (DEPTH, D_MODEL, IN_WIDTH), D_MODEL ** -0.5),
        'g_q': gain(ks[10], (DEPTH, N_GROUPS, HEAD_DIM)),
        'g_k': gain(ks[11], (DEPTH, N_GROUPS, HEAD_DIM)),
        'hg_lb_raw': nrm(ks[12], (DEPTH + 1, HG_FDIM), 0.1),
        'g_hg_out': gain(ks[13], (DEPTH, HG_VDIM)),
        'w_up_attn': nrm(ks[14], (DEPTH, A_WIDTH, D_MODEL), A_WIDTH ** -0.5),
        'w_up_hgrn': nrm(ks[15], (DEPTH, HG_WIDTH, D_MODEL), HG_WIDTH ** -0.5),
        'w_out': nrm(ks[16], (DEPTH, D_MODEL, D_MODEL), D_MODEL ** -0.5),
        'g_ffn': gain(ks[17], (DEPTH, D_MODEL)),
        'w_ff_up': nrm(ks[18], (DEPTH, D_MODEL, FFN_HIDDEN), D_MODEL ** -0.5),
        'w_ff_down': nrm(ks[19], (DEPTH, FFN_HIDDEN, D_MODEL), FFN_HIDDEN ** -0.5),
        'w_ple': nrm(ks[20], (DEPTH, PLE_DIM, D_MODEL), PLE_DIM ** -0.5),
        'w_ple_gate': nrm(ks[21], (DEPTH, D_MODEL, D_MODEL), D_MODEL ** -0.5),
    }


def reference(x_prompt, x_sample, cache_kv_w128, cache_kv_w512, cache_kv_w2048, state_hgrn,
              p_prompt, p_sample, g_mix, w_in, g_q, g_k, hg_lb_raw, g_hg_out, w_up_attn, w_up_hgrn,
              w_out, g_ffn, w_ff_up, w_ff_down, w_ple, w_ple_gate):
    slopes = _alibi_slopes()
    lb_all = jnp.cumsum(jax.nn.softmax(hg_lb_raw.astype(jnp.float32), axis=0), axis=0)
    yp, ys = x_prompt, x_sample
    kvp = ([], [], [])
    kvs = ([], [], [])
    stp, sts = [], []
    for i in range(DEPTH):
        lw = (lb_all[i], g_mix[i], w_in[i], g_q[i], g_k[i], g_hg_out[i], w_up_attn[i], w_up_hgrn[i],
              w_out[i], g_ffn[i], w_ff_up[i], w_ff_down[i], w_ple[i], w_ple_gate[i])
        s0p = jnp.zeros((x_prompt.shape[0], HG_HEADS, HG_KDIM, HG_VDIM), x_prompt.dtype)
        yp, rows_p, s_p = _layer(yp, p_prompt[i], s0p, functools.partial(_attend_prompt, slopes=slopes), *lw)
        caches = (cache_kv_w128[i], cache_kv_w512[i], cache_kv_w2048[i])
        ys, rows_s, s_s = _layer(ys, p_sample[i], state_hgrn[i],
                                 functools.partial(_attend_sample, caches=caches, slopes=slopes), *lw)
        for g in range(N_GROUPS):
            kvp[g].append(rows_p[g])
            kvs[g].append(rows_s[g])
        stp.append(s_p)
        sts.append(s_s)
    kv128_p, kv512_p, kv2048_p = jnp.stack(kvp[0]), jnp.stack(kvp[1]), jnp.stack(kvp[2])
    kv128_s, kv512_s, kv2048_s = jnp.stack(kvs[0]), jnp.stack(kvs[1]), jnp.stack(kvs[2])
    hg_p, hg_s = jnp.stack(stp), jnp.stack(sts)
    return (yp, ys, kv128_p, kv512_p, kv2048_p, hg_p, kv128_s, kv512_s, kv2048_s, hg_s)
```

```cpp
#include <hip/hip_runtime.h>
#include <cstdio>
#include <cstdint>
#include <cstring>

namespace pg8 {
#define PG8_LAS __attribute__((address_space(3)))
typedef unsigned short bf16_t;
typedef short bf16x8 __attribute__((ext_vector_type(8)));
typedef float f32x4 __attribute__((ext_vector_type(4)));
typedef unsigned u32x4 __attribute__((ext_vector_type(4)));
constexpr int BM = 256, BK = 64, HALF = 128, HTB = HALF * BK * 2  , STAGE_BYTES = 8 * HTB, NXCD = 8, WGM = 8;

__host__ __device__ __forceinline__ int lds_byte(int r, int c) { const int st = (r >> 4) * 2 + (c >> 5), rr = r & 15, cc = c & 31, ob = rr * 64 + cc * 2; return st * 1024 + (ob ^ (((ob >> 9) & 1) << 5)); }
__host__ __device__ __forceinline__ void stage_rc(int b, int& R, int& C) { const int st = b / 1024, sb = b % 1024, swz = sb ^ (((sb >> 9) & 1) << 5); R = (st >> 1) * 16 + swz / 64; C = (st & 1) * 32 + (swz % 64) / 2; }
__host__ __device__ __forceinline__ int perm32(int rho) { const int n = rho >> 4, i = rho & 15; return 8 * (i >> 2) + 4 * n + (i & 3); }

struct Unit { int pm, pn; };
struct Gemm { const bf16_t* A; const bf16_t* Bt; int M, N, K; };

struct StaticOrder {
    int nM, nN, nwg, G, c;
    __host__ __device__ void init(int M, int N, int G_, int c_) { nM = M / BM; nN = N / BM; nwg = nM * nN; G = G_; c = c_; }
    __host__ __device__ bool next(int i, Unit& u) const {
        const long L = (long)i * G + c; if (L >= nwg) return false;
        int wgid = (int)L; { const int q = nwg / NXCD, r = nwg % NXCD, xcd = wgid % NXCD, off = wgid / NXCD; wgid = (xcd < r ? xcd * (q + 1) : r * (q + 1) + (xcd - r) * q) + off; }
        const int nig = WGM * nN, gid = wgid / nig, fm = gid * WGM, gsz = (nM - fm) < WGM ? (nM - fm) : WGM;
        u.pm = fm + ((wgid % nig) % gsz); u.pn = (wgid % nig) / gsz; return true;
    }
    __device__ __forceinline__ void a_ready(const Unit&) const {}
    __device__ __forceinline__ void done(const Unit&) const {}
};

__device__ __forceinline__ unsigned cvt_pk_bf16(float lo, float hi) { unsigned r; asm volatile("v_cvt_pk_bf16_f32 %0, %1, %2" : "=v"(r) : "v"(lo), "v"(hi)); return r; }
__device__ __forceinline__ float sigm(float x) { return 1.0f / (1.0f + __expf(-x)); }
__device__ __forceinline__ void st_bf16x8(bf16_t* p, const f32x4 a, const f32x4 b) {
    u32x4 w; w.x = cvt_pk_bf16(a[0], a[1]); w.y = cvt_pk_bf16(a[2], a[3]); w.z = cvt_pk_bf16(b[0], b[1]); w.w = cvt_pk_bf16(b[2], b[3]); *(u32x4*)p = w; }
__device__ __forceinline__ void ld_bf16x8(const bf16_t* p, f32x4& a, f32x4& b) {
    const u32x4 w = *(const u32x4*)p;
    a[0] = __uint_as_float(w.x << 16); a[1] = __uint_as_float(w.x & 0xffff0000u); a[2] = __uint_as_float(w.y << 16); a[3] = __uint_as_float(w.y & 0xffff0000u);
    b[0] = __uint_as_float(w.z << 16); b[1] = __uint_as_float(w.z & 0xffff0000u); b[2] = __uint_as_float(w.w << 16); b[3] = __uint_as_float(w.w & 0xffff0000u); }
__device__ __forceinline__ f32x4 sigm4(const f32x4 v) { f32x4 o; o[0] = sigm(v[0]); o[1] = sigm(v[1]); o[2] = sigm(v[2]); o[3] = sigm(v[3]); return o; }

constexpr int TOK_P = 8192, TOK_ALL = 8448;
constexpr float NEPS = 1e-6f;
constexpr size_t O_Y = 0, O_KV128P = 34603008, O_KV512P = 34865152, O_KV2048P = 35913728, O_STP = 40108032,
                 O_KV128S = 40370176, O_KV512S = 40894464, O_KV2048S = 41418752, O_STS = 41943040, O_TOTAL = 50331648;

__device__ __forceinline__ void kv_store(float* out, int g, int row, int kvsel, int hd, const f32x4 a, const f32x4 b) {
    float* dst;
    if (row >= TOK_P) {
        const size_t base = g == 0 ? O_KV128S : (g == 1 ? O_KV512S : O_KV2048S);
        dst = out + base + ((size_t)(row - TOK_P) * 2 + kvsel) * 1024 + hd;
    } else {
        const int L = 128 << (2 * g);
        if (row < TOK_P - L) return;
        const size_t base = g == 0 ? O_KV128P : (g == 1 ? O_KV512P : O_KV2048P);
        dst = out + base + ((size_t)(row - (TOK_P - L)) * 2 + kvsel) * 1024 + hd;
    }
    *(f32x4*)dst = a; *(f32x4*)(dst + 4) = b;
}

struct EpiIn {
    static constexpr bool PERM = true, AFTER_DRAIN = false;
    bf16_t *Q, *K, *V, *HQ, *KK, *HI, *OG, *SA, *SB; float* LG;
    const float *r0, *gq, *gk, *lbraw; float* out; PG8_LAS float* tab;
    __device__ __forceinline__ void operator()(const f32x4 (&acc)[2][2][4][2], const Unit& u, int wr, int wc, int fr, int fq) const {
        const int pn = u.pn;
        const int row0 = u.pm * BM + wr * 64 + fr;
        const int cl = wc * 32 + 8 * fq;
        if (pn < 24) {
            const bool isk = pn >= 12;
            const int cb = (isk ? pn - 12 : pn) * 256;
#pragma unroll
            for (int ai = 0; ai < 2; ++ai)
#pragma unroll
                for (int m = 0; m < 4; ++m) {
                    const float rs = r0[row0 + ai * HALF + m * 16];
#pragma unroll
                    for (int bj = 0; bj < 2; ++bj) {
                        const f32x4 a = acc[ai][bj][m][0] * rs, b = acc[ai][bj][m][1] * rs;
                        float s = (a[0] * a[0] + a[1] * a[1]) + (a[2] * a[2] + a[3] * a[3]) + (b[0] * b[0] + b[1] * b[1]) + (b[2] * b[2] + b[3] * b[3]);
                        s += __shfl_xor(s, 16); s += __shfl_xor(s, 32);
                        if (fq == 0) tab[((ai * HALF + wr * 64 + m * 16 + fr) * 2 + bj) * 4 + wc] = s;
                    }
                }
            asm volatile("s_waitcnt lgkmcnt(0)" ::: "memory"); __builtin_amdgcn_s_barrier(); asm volatile("" ::: "memory");
            const float* gain = isk ? gk : gq;
#pragma unroll
            for (int ai = 0; ai < 2; ++ai)
#pragma unroll
                for (int m = 0; m < 4; ++m) {
                    const int row = row0 + ai * HALF + m * 16;
                    const float rs = r0[row];
#pragma unroll
                    for (int bj = 0; bj < 2; ++bj) {
                        const f32x4 t = *(const PG8_LAS f32x4*)&tab[((ai * HALF + wr * 64 + m * 16 + fr) * 2 + bj) * 4];
                        const float sc = rs * rsqrtf(((t[0] + t[1]) + (t[2] + t[3])) * (1.0f / 128.0f) + NEPS);
                        const int col = cb + bj * HALF + cl;
                        const int g = col >> 10;
                        const f32x4 g0 = *(const f32x4*)(gain + g * 128 + cl), g1 = *(const f32x4*)(gain + g * 128 + cl + 4);
                        const f32x4 a = acc[ai][bj][m][0] * sc * g0, b = acc[ai][bj][m][1] * sc * g1;
                        st_bf16x8((isk ? K : Q) + (size_t)row * 3072 + col, a, b);
                        if (isk) kv_store(out, g, row, 0, col & 1023, a, b);
                    }
                }
            return;
        }
#pragma unroll
        for (int ai = 0; ai < 2; ++ai)
#pragma unroll
            for (int m = 0; m < 4; ++m) {
                const int row = row0 + ai * HALF + m * 16;
                const float rs = r0[row];
#pragma unroll
                for (int bj = 0; bj < 2; ++bj) {
                    f32x4 a = acc[ai][bj][m][0] * rs, b = acc[ai][bj][m][1] * rs;
                    const int ct = bj * HALF + cl;
                    if (pn < 36) {
                        const int col = (pn - 24) * 256 + ct;
                        st_bf16x8(V + (size_t)row * 3072 + col, a, b);
                        kv_store(out, col >> 10, row, 1, col & 1023, a, b);
                    } else if (pn < 44) {
                        const int col = (pn - 36) * 256 + ct;
                        a = a * sigm4(a) * 0.08838834764831845f; b = b * sigm4(b) * 0.08838834764831845f;
                        st_bf16x8(HQ + (size_t)row * 2048 + col, a, b);
                    } else if (pn < 52) {
                        const int col = (pn - 44) * 256 + ct;
                        f32x4 l0a = *(const f32x4*)(lbraw + col), l0b = *(const f32x4*)(lbraw + col + 4), l1a = *(const f32x4*)(lbraw + 2048 + col), l1b = *(const f32x4*)(lbraw + 2048 + col + 4);
                        f32x4 lga, lgb, ka, kb;
#pragma unroll
                        for (int j = 0; j < 4; ++j) {
                            const float lba = 1.0f / (1.0f + __expf(l1a[j] - l0a[j])), lbb = 1.0f / (1.0f + __expf(l1b[j] - l0b[j]));
                            const float sa_ = sigm(a[j]), sb_ = sigm(b[j]);
                            lga[j] = __logf(lba + (1.0f - lba) * sa_); lgb[j] = __logf(lbb + (1.0f - lbb) * sb_);
                            ka[j] = (1.0f - lba) * sigm(-a[j]); kb[j] = (1.0f - lbb) * sigm(-b[j]);
                        }
                        float* lp = LG + (size_t)row * 2048 + col; *(f32x4*)lp = lga; *(f32x4*)(lp + 4) = lgb;
                        st_bf16x8(KK + (size_t)row * 2048 + col, ka, kb);
                    } else if (pn < 60) {
                        const int col = (pn - 52) * 256 + ct;
                        st_bf16x8(HI + (size_t)row * 2048 + col, a, b);
                    } else if (pn < 68) {
                        const int col = (pn - 60) * 256 + ct;
                        st_bf16x8(OG + (size_t)row * 2048 + col, sigm4(a), sigm4(b));
                    } else if (pn < 84) {
                        const int col = (pn - 68) * 256 + ct;
                        st_bf16x8(SA + (size_t)row * 4096 + col, sigm4(a), sigm4(b));
                    } else {
                        const int col = (pn - 84) * 256 + ct;
                        st_bf16x8(SB + (size_t)row * 4096 + col, sigm4(a), sigm4(b));
                    }
                }
            }
    }
};

template <int KIND> struct EpiEw {
    static constexpr bool PERM = true, AFTER_DRAIN = false;
    bf16_t* O; const bf16_t* G1; const bf16_t* O2; float* F; const float* XP; const float* XS; float* ssq; int ldc;
    __device__ __forceinline__ void operator()(const f32x4 (&acc)[2][2][4][2], const Unit& u, int wr, int wc, int fr, int fq) const {
        const int row0 = u.pm * BM + wr * 64 + fr;
        const int col0 = u.pn * BM + wc * 32 + 8 * fq;
#pragma unroll
        for (int ai = 0; ai < 2; ++ai)
#pragma unroll
            for (int m = 0; m < 4; ++m) {
                const int row = row0 + ai * HALF + m * 16;
                float rs = 0.f, ss = 0.f;
                if (KIND == 4) rs = rsqrtf(ssq[row] * (1.0f / 4096.0f) + NEPS);
#pragma unroll
                for (int bj = 0; bj < 2; ++bj) {
                    const int col = col0 + bj * HALF;
                    const size_t off = (size_t)row * ldc + col;
                    f32x4 a = acc[ai][bj][m][0], b = acc[ai][bj][m][1];
                    if (KIND == 0) { st_bf16x8(O + off, a, b); }
                    if (KIND == 1) { f32x4 ga, gb; ld_bf16x8(G1 + off, ga, gb); st_bf16x8(O + off, a * ga, b * gb); }
                    if (KIND == 2) { f32x4 ga, gb, pa, pb; ld_bf16x8(G1 + off, ga, gb); ld_bf16x8(O2 + off, pa, pb); st_bf16x8(O + off, pa + a * ga, pb + b * gb); }
                    if (KIND == 3) {
                        const float* xr = row < TOK_P ? XP + (size_t)row * 4096 + col : XS + (size_t)(row - TOK_P) * 4096 + col;
                        a += *(const f32x4*)xr; b += *(const f32x4*)(xr + 4);
                        *(f32x4*)(F + off) = a; *(f32x4*)(F + off + 4) = b; st_bf16x8(O + off, a, b);
                        ss += (a[0] * a[0] + a[1] * a[1]) + (a[2] * a[2] + a[3] * a[3]) + (b[0] * b[0] + b[1] * b[1]) + (b[2] * b[2] + b[3] * b[3]);
                    }
                    if (KIND == 4) {
#pragma unroll
                        for (int j = 0; j < 4; ++j) { const float x = fmaxf(a[j] * rs, 0.f), y = fmaxf(b[j] * rs, 0.f); a[j] = x * x; b[j] = y * y; }
                        st_bf16x8(O + off, a, b);
                    }
                    if (KIND == 5) { a += *(const f32x4*)(F + off); b += *(const f32x4*)(F + off + 4); *(f32x4*)(F + off) = a; *(f32x4*)(F + off + 4) = b; st_bf16x8(O + off, a, b); }
                    if (KIND == 6) { f32x4 ga, gb; ld_bf16x8(G1 + off, ga, gb); a = *(const f32x4*)(F + off) + sigm4(a) * ga; b = *(const f32x4*)(F + off + 4) + sigm4(b) * gb; *(f32x4*)(F + off) = a; *(f32x4*)(F + off + 4) = b; }
                }
                if (KIND == 3) { ss += __shfl_xor(ss, 16); ss += __shfl_xor(ss, 32); if (fq == 0) atomicAdd(ssq + row, ss); }
            }
    }
};

template <class Epi, class Sched, bool ALIGN_EPI = false, bool SP2 = false>
__device__ __forceinline__ void gemm_phase(PG8_LAS unsigned char* lds, const Gemm g, const Sched& S, const Epi& E) {
    const int tid = threadIdx.x, wid = __builtin_amdgcn_readfirstlane(tid >> 6), lane = tid & 63, wr = wid >> 2, wc = wid & 3, fr = lane & 15, fq = lane >> 4;
    const int K = g.K, nt = K / BK;
    unsigned voffA[2], voffB[2];
#pragma unroll
    for (int i = 0; i < 2; ++i) { int R, C; stage_rc(tid * 16 + i * 8192, R, C); const int Rb = Epi::PERM ? ((R & ~31) + perm32(R & 31)) : R;
        voffA[i] = (unsigned)(R * K + C) * 2u; voffB[i] = (unsigned)(Rb * K + C) * 2u; }
    const size_t kstep = (size_t)(BK * 2);
    const size_t hstep = (size_t)HALF * K * 2;
    const size_t tstep = 2 * hstep;
    const unsigned ldsw = (unsigned)wid * 1024u;
    const int aoff = lds_byte(wr * 64 + fr, fq * 8), boff = lds_byte(wc * 32 + fr, fq * 8);
#define PG8_SA(b, h) (((b) * 2 + (h)) * HTB)
#define PG8_SB(b, h) ((4 + (b) * 2 + (h)) * HTB)
#define PG8_STAGE(bufoff, gbase, voff) do { _Pragma("unroll") for (int _i = 0; _i < 2; ++_i) \
        __builtin_amdgcn_global_load_lds((const unsigned*)((const char*)(gbase) + (voff)[_i]), (PG8_LAS unsigned*)(lds + (bufoff) + ldsw + _i * 8192), 16, 0, 0); } while (0)
#define PG8_LDA(dst, b, h) do { _Pragma("unroll") for (int m = 0; m < 4; ++m) _Pragma("unroll") for (int k = 0; k < 2; ++k) dst[m][k] = *(const PG8_LAS bf16x8*)(lds + PG8_SA(b, h) + aoff + m * 2048 + k * 1024); } while (0)
#define PG8_LDB(dst, b, h) do { _Pragma("unroll") for (int n = 0; n < 2; ++n) _Pragma("unroll") for (int k = 0; k < 2; ++k) dst[n][k] = *(const PG8_LAS bf16x8*)(lds + PG8_SB(b, h) + boff + n * 2048 + k * 1024); } while (0)
#define PG8_MMA(ai, bj, At, Bt) do { __builtin_amdgcn_s_setprio(1); _Pragma("unroll") for (int m = 0; m < 4; ++m) _Pragma("unroll") for (int n = 0; n < 2; ++n) _Pragma("unroll") for (int k = 0; k < 2; ++k) \
        acc[ai][bj][m][n] = __builtin_amdgcn_mfma_f32_16x16x32_bf16(Bt[n][k], At[m][k], acc[ai][bj][m][n], 0, 0, 0); __builtin_amdgcn_s_setprio(0); } while (0)
#define PG8_WAIT_V(n) asm volatile("s_waitcnt vmcnt(" #n ")" ::: "memory")
#define PG8_WAIT_L(n) asm volatile("s_waitcnt lgkmcnt(" #n ")" ::: "memory")
#define PG8_BAR __builtin_amdgcn_s_barrier()
#define PG8_SCHED __builtin_amdgcn_sched_barrier(0)
    Unit cur, nxt; int ui = 0;
    if (!S.next(0, cur)) return;
    f32x4 acc[2][2][4][2];
#pragma unroll
    for (int a = 0; a < 2; ++a)
#pragma unroll
        for (int b = 0; b < 2; ++b)
#pragma unroll
            for (int m = 0; m < 4; ++m)
#pragma unroll
                for (int n = 0; n < 2; ++n) acc[a][b][m][n] = (f32x4){0.f, 0.f, 0.f, 0.f};
    bf16x8 At[4][2], B0[2][2], B1[2][2];
    const char* cA = (const char*)g.A + (size_t)cur.pm * tstep; const char* cB = (const char*)g.Bt + (size_t)cur.pn * tstep;
    S.a_ready(cur);
    if constexpr (SP2) {
        PG8_STAGE(PG8_SB(0, 0), cB, voffB); PG8_STAGE(PG8_SB(0, 1), cB + hstep, voffB); PG8_STAGE(PG8_SA(0, 0), cA, voffA); PG8_STAGE(PG8_SA(0, 1), cA + hstep, voffA);
        if (wr == 1) PG8_BAR;
        PG8_WAIT_V(2); PG8_BAR;
        PG8_STAGE(PG8_SB(1, 0), cB + kstep, voffB); PG8_STAGE(PG8_SA(1, 0), cA + kstep, voffA); PG8_STAGE(PG8_SB(1, 1), cB + hstep + kstep, voffB);
        PG8_WAIT_V(6); PG8_BAR;
    } else {
        PG8_STAGE(PG8_SB(0, 0), cB, voffB); PG8_STAGE(PG8_SA(0, 0), cA, voffA); PG8_STAGE(PG8_SB(0, 1), cB + hstep, voffB); PG8_STAGE(PG8_SA(0, 1), cA + hstep, voffA);
        if (wr == 1) PG8_BAR;
        PG8_WAIT_V(4); PG8_BAR;
        PG8_STAGE(PG8_SB(1, 0), cB + kstep, voffB); PG8_STAGE(PG8_SA(1, 0), cA + kstep, voffA); PG8_STAGE(PG8_SB(1, 1), cB + hstep + kstep, voffB);
        PG8_WAIT_V(6); PG8_BAR;
    }
    for (;;) {
        const bool has_next = S.next(ui + 1, nxt);
        const char* nA = has_next ? (const char*)g.A + (size_t)nxt.pm * tstep : cA; const char* nB = has_next ? (const char*)g.Bt + (size_t)nxt.pn * tstep : cB;
        for (int t = 0; t < nt; t += 2) {
            const bool last = (t == nt - 2);
            const char* a1 = cA + (size_t)(t + 1) * kstep;
            const char* a2 = last ? nA : cA + (size_t)(t + 2) * kstep; const char* b2 = last ? nB : cB + (size_t)(t + 2) * kstep;
            const char* a3 = a2 + kstep; const char* b3 = b2 + kstep;
            if (last && has_next) S.a_ready(nxt);
            if constexpr (SP2) {
            PG8_LDB(B0, 0, 0); PG8_LDB(B1, 0, 1); PG8_SCHED; PG8_LDA(At, 0, 0); PG8_STAGE(PG8_SA(1, 1), a1 + hstep, voffA);
            PG8_WAIT_V(8); PG8_WAIT_L(0); PG8_BAR; PG8_MMA(0, 0, At, B0); PG8_MMA(0, 1, At, B1); PG8_BAR; PG8_SCHED;
            PG8_LDA(At, 0, 1); PG8_STAGE(PG8_SB(0, 0), b2, voffB); PG8_STAGE(PG8_SB(0, 1), b2 + hstep, voffB); PG8_STAGE(PG8_SA(0, 0), a2, voffA);
            PG8_WAIT_V(8); PG8_WAIT_L(0); PG8_BAR; PG8_MMA(1, 0, At, B0); PG8_MMA(1, 1, At, B1); PG8_BAR; PG8_SCHED;
            PG8_LDB(B0, 1, 0); PG8_LDB(B1, 1, 1); PG8_SCHED; PG8_LDA(At, 1, 0); PG8_STAGE(PG8_SA(0, 1), a2 + hstep, voffA);
            PG8_WAIT_V(8); PG8_WAIT_L(0); PG8_BAR; PG8_MMA(0, 0, At, B0); PG8_MMA(0, 1, At, B1); PG8_BAR; PG8_SCHED;
            PG8_LDA(At, 1, 1); PG8_STAGE(PG8_SB(1, 0), b3, voffB); PG8_STAGE(PG8_SB(1, 1), b3 + hstep, voffB); PG8_STAGE(PG8_SA(1, 0), a3, voffA);
            PG8_WAIT_V(8); PG8_WAIT_L(0); PG8_BAR; PG8_MMA(1, 0, At, B0); PG8_MMA(1, 1, At, B1); PG8_BAR; PG8_SCHED;
            } else {
            PG8_LDB(B0, 0, 0); PG8_SCHED; PG8_LDA(At, 0, 0); PG8_STAGE(PG8_SA(1, 1), a1 + hstep, voffA);
            PG8_WAIT_L(8); PG8_BAR; PG8_WAIT_L(0); PG8_MMA(0, 0, At, B0); PG8_BAR; PG8_SCHED;
            PG8_LDB(B1, 0, 1); PG8_STAGE(PG8_SB(0, 0), b2, voffB);
            PG8_BAR; PG8_WAIT_L(0); PG8_MMA(0, 1, At, B1); PG8_BAR;
            PG8_LDA(At, 0, 1); PG8_STAGE(PG8_SA(0, 0), a2, voffA);
            PG8_BAR; PG8_WAIT_L(0); PG8_MMA(1, 0, At, B0); PG8_BAR; PG8_SCHED;
            PG8_STAGE(PG8_SB(0, 1), b2 + hstep, voffB);
            PG8_WAIT_V(6); PG8_BAR; PG8_MMA(1, 1, At, B1); PG8_BAR;
            PG8_LDB(B0, 1, 0); PG8_SCHED; PG8_LDA(At, 1, 0); PG8_STAGE(PG8_SA(0, 1), a2 + hstep, voffA);
            PG8_WAIT_L(8); PG8_BAR; PG8_WAIT_L(0); PG8_MMA(0, 0, At, B0); PG8_BAR; PG8_SCHED;
            PG8_LDB(B1, 1, 1); PG8_STAGE(PG8_SB(1, 0), b3, voffB);
            PG8_BAR; PG8_WAIT_L(0); PG8_MMA(0, 1, At, B1); PG8_BAR;
            PG8_LDA(At, 1, 1); PG8_STAGE(PG8_SA(1, 0), a3, voffA);
            PG8_BAR; PG8_WAIT_L(0); PG8_MMA(1, 0, At, B0); PG8_BAR; PG8_SCHED;
            PG8_STAGE(PG8_SB(1, 1), b3 + hstep, voffB);
            PG8_WAIT_V(6); PG8_BAR; PG8_MMA(1, 1, At, B1); PG8_BAR;
            }
        }
        if constexpr (ALIGN_EPI) { if (wr == 0) PG8_BAR; }
        if constexpr (!Epi::AFTER_DRAIN) { E(acc, cur, wr, wc, fr, fq); S.done(cur); }
        if (!has_next) break;
#pragma unroll
        for (int a = 0; a < 2; ++a)
#pragma unroll
            for (int b = 0; b < 2; ++b)
#pragma unroll
                for (int m = 0; m < 4; ++m)
#pragma unroll
                    for (int n = 0; n < 2; ++n) acc[a][b][m][n] = (f32x4){0.f, 0.f, 0.f, 0.f};
        cur = nxt; cA = nA; cB = nB; ++ui;
        if constexpr (ALIGN_EPI) { if (wr == 1) PG8_BAR; }
    }
    PG8_WAIT_V(0);
    if constexpr (!ALIGN_EPI) { if (wr == 0) PG8_BAR; }
    PG8_BAR;
    if constexpr (Epi::AFTER_DRAIN) { E.fused(acc, cur, wr, wc, fr, fq, lds, wid, lane); S.done(cur); }
#undef PG8_SA
#undef PG8_SB
#undef PG8_STAGE
#undef PG8_LDA
#undef PG8_LDB
#undef PG8_MMA
#undef PG8_WAIT_V
#undef PG8_WAIT_L
#undef PG8_BAR
#undef PG8_SCHED
}
}

#define GAS __attribute__((address_space(1)))
#define LAS __attribute__((address_space(3)))
typedef unsigned short bf16;
typedef unsigned v4u __attribute__((ext_vector_type(4)));
typedef float f32x4 __attribute__((ext_vector_type(4)));
typedef short bf16x8 __attribute__((ext_vector_type(8)));
typedef GAS unsigned gu32;
typedef GAS unsigned long long gu64;
#define RLX_AGENT __ATOMIC_RELAXED, __HIP_MEMORY_SCOPE_AGENT
#define LDS_WAIT() asm volatile("s_waitcnt lgkmcnt(0)" ::: "memory")
#define VM_WAIT() asm volatile("s_waitcnt vmcnt(0)" ::: "memory")
__device__ __forceinline__ unsigned long long rt() { return __builtin_amdgcn_s_memrealtime(); }
__device__ __forceinline__ unsigned f2bf(float f) { unsigned u = __builtin_bit_cast(unsigned, f); return (u + 0x7fffu + ((u >> 16) & 1u)) >> 16; }
__device__ __forceinline__ unsigned pk2(float lo, float hi) { return f2bf(lo) | (f2bf(hi) << 16); }

#define XB_TMO      128
#define XB_XCNT(j)  (256  + 64 * (j))
#define XB_XSUB(j)  (1280 + 64 * (j))
#define XB_XGEN(j)  (2304 + 64 * (j))
#define XB_TOP      3328
#define XB_TOPGEN   3392
#define XCD_BAR_WORDS 3456
#define XB_SPIN_CAP (1u << 18)

__device__ __forceinline__ unsigned xb_ld(unsigned* p)              { return __hip_atomic_load(p, __ATOMIC_RELAXED, __HIP_MEMORY_SCOPE_AGENT); }
__device__ __forceinline__ unsigned xb_add(unsigned* p, unsigned v) { return __hip_atomic_fetch_add(p, v, __ATOMIC_RELAXED, __HIP_MEMORY_SCOPE_AGENT); }
__device__ __forceinline__ unsigned xb_xcc_id() { return (unsigned)__builtin_amdgcn_s_getreg((3 << 11) | 20) & 0xFu; }
#define XB_SPIN(cond, bar) do { unsigned _sp = 0; while (cond) { __builtin_amdgcn_s_sleep(1); \
    if ((++_sp & 255u) == 0u) { if (xb_ld(&(bar)[XB_TMO])) break; if (_sp > XB_SPIN_CAP) { atomicAdd(&(bar)[XB_TMO], 1u); break; } } } } while (0)

struct XcdBarrier {
    unsigned* bar; unsigned x;
    volatile LAS unsigned* st;
};

__device__ __forceinline__ XcdBarrier xcd_barrier_post(unsigned* bar, volatile LAS unsigned* st) {
    XcdBarrier b; b.bar = bar; b.x = xb_xcc_id(); b.st = st;
    if (threadIdx.x == 0) (void)xb_add(&bar[XB_XCNT(b.x)], 1u);
    return b;
}
__device__ __forceinline__ void xcd_barrier_complete(unsigned* bar, unsigned x, unsigned& nloc, unsigned& nx) {
    const unsigned G = gridDim.x * gridDim.y * gridDim.z;
    unsigned sum, cnt, mine, sp = 0u;
    for (;;) {
        sum = 0u; cnt = 0u; mine = 0u;
#pragma unroll
        for (unsigned j = 0; j < 16; ++j) { const unsigned c = xb_ld(&bar[XB_XCNT(j)]); sum += c; cnt += (c > 0u) ? 1u : 0u; mine = (j == x) ? c : mine; }
        if (sum == G) break;
        __builtin_amdgcn_s_sleep(1);
        if ((++sp & 255u) == 0u) { if (xb_ld(&bar[XB_TMO])) break; if (sp > XB_SPIN_CAP) { atomicAdd(&bar[XB_TMO], 1u); break; } }
    }
    nloc = mine > 0u ? mine : 1u; nx = cnt > 0u ? cnt : 1u;
}

__device__ __forceinline__ void xcd_barrier(const XcdBarrier& b) {
    asm volatile("s_waitcnt vmcnt(0)" ::: "memory");
    __syncthreads();
    if (threadIdx.x == 0) {
        unsigned* bar = b.bar;
        __builtin_amdgcn_s_waitcnt(0);
        unsigned nloc = b.st[0], nx = b.st[1];
        if (nloc == 0u) { xcd_barrier_complete(bar, b.x, nloc, nx); b.st[0] = nloc; b.st[1] = nx; }
        const unsigned old = xb_add(&bar[XB_XSUB(b.x)], 1u);
        const unsigned gen = old / nloc;
        if (old + 1u == (gen + 1u) * nloc) {
            __builtin_amdgcn_fence(__ATOMIC_RELEASE, "agent");
            asm volatile("s_waitcnt vmcnt(0)" ::: "memory");
            const unsigned og = xb_add(&bar[XB_TOP], 1u);
            const unsigned tg = og / nx;
            if (og + 1u == (tg + 1u) * nx) xb_add(&bar[XB_TOPGEN], 1u);
            else XB_SPIN(xb_ld(&bar[XB_TOPGEN]) == tg, bar);
            __builtin_amdgcn_fence(__ATOMIC_ACQUIRE, "agent");
            xb_add(&bar[XB_XGEN(b.x)], 1u);
            asm volatile("s_waitcnt vmcnt(0)" ::: "memory");
        } else {
            XB_SPIN(xb_ld(&bar[XB_XGEN(b.x)]) == gen, bar);
            __builtin_amdgcn_fence(__ATOMIC_ACQUIRE, "agent");
            asm volatile("s_waitcnt vmcnt(0)" ::: "memory");
        }
    }
    __syncthreads();
}

constexpr int NWAVES = 8;
constexpr int DM = 4096, TOKP = 8192, TOKS = 256, MTOK = TOKP + TOKS, INW = 25600, FFH = 16384, PLED = 256;
constexpr int AW = 1024, HGW = 2048;
constexpr size_t al256(size_t x) { return (x + 255) & ~(size_t)255; }
constexpr size_t WS_CTL = 0, CTL_ZERO_BYTES = 1u << 20;
constexpr size_t WS_WIN   = CTL_ZERO_BYTES;
constexpr size_t WS_WFFU  = WS_WIN  + (size_t)INW * DM * 2;
constexpr size_t WS_WFFD  = WS_WFFU + (size_t)FFH * DM * 2;
constexpr size_t WS_WOUT  = WS_WFFD + (size_t)DM * FFH * 2;
constexpr size_t WS_WPG   = WS_WOUT + (size_t)DM * DM * 2;
constexpr size_t WS_WUPA  = WS_WPG  + (size_t)DM * DM * 2;
constexpr size_t WS_WUPH  = WS_WUPA + (size_t)DM * AW * 2;
constexpr size_t WS_WPLE  = WS_WUPH + (size_t)DM * HGW * 2;
constexpr size_t WS_XB    = WS_WPLE + (size_t)DM * PLED * 2;
constexpr size_t WS_R0    = WS_XB   + (size_t)MTOK * DM * 2;
constexpr size_t WS_PB    = al256(WS_R0 + (size_t)MTOK * 4);
constexpr size_t WS_Q     = WS_PB   + (size_t)MTOK * PLED * 2;
constexpr size_t WS_K     = WS_Q    + (size_t)MTOK * 3072 * 2;
constexpr size_t WS_V     = WS_K    + (size_t)MTOK * 3072 * 2;
constexpr size_t WS_HQ    = WS_V    + (size_t)MTOK * 3072 * 2;
constexpr size_t WS_KK    = WS_HQ   + (size_t)MTOK * HGW * 2;
constexpr size_t WS_HI    = WS_KK   + (size_t)MTOK * HGW * 2;
constexpr size_t WS_OG    = WS_HI   + (size_t)MTOK * HGW * 2;
constexpr size_t WS_LG    = WS_OG   + (size_t)MTOK * HGW * 2;
constexpr size_t WS_SA    = WS_LG   + (size_t)MTOK * HGW * 4;
constexpr size_t WS_SB    = WS_SA   + (size_t)MTOK * DM * 2;
constexpr size_t WS_PP    = WS_SB   + (size_t)MTOK * DM * 2;
constexpr size_t WS_OATT  = WS_PP   + (size_t)MTOK * DM * 2;
constexpr size_t WS_OHG   = WS_OATT + (size_t)MTOK * AW * 2;
constexpr size_t WS_P1B   = WS_OHG  + (size_t)MTOK * HGW * 2;
constexpr size_t WS_MRG   = WS_P1B  + (size_t)MTOK * DM * 2;
constexpr size_t WS_X1B   = WS_MRG  + (size_t)MTOK * DM * 2;
constexpr size_t WS_X2B   = WS_X1B  + (size_t)MTOK * DM * 2;
constexpr size_t WS_U     = WS_X2B  + (size_t)MTOK * DM * 2;
constexpr size_t WS_END   = WS_U    + (size_t)MTOK * FFH * 2;
constexpr int CW_BAR = 4096;
constexpr int CW_SSQ = 16384;
static_assert((CW_SSQ + MTOK) * 4 <= (int)CTL_ZERO_BYTES && CW_BAR + XCD_BAR_WORDS <= CW_SSQ, "CTL map");
constexpr int RING_OFF = 0, RING_BYTES = 131072;
constexpr int TAB_OFF = RING_BYTES;
constexpr int MISC_OFF = TAB_OFF + 8192;
constexpr int LDS_BYTES = 147456;
static_assert(MISC_OFF + 128 <= LDS_BYTES, "LDS map");

struct Args {
    const float* in[22]; float* out; unsigned char* ws; int ph_lo, ph_hi;
};
static_assert(sizeof(Args) == 22 * 8 + 8 + 8 + 8, "no padding");

__device__ __forceinline__ float wave_sum(float v) {
#pragma unroll
    for (int o = 1; o < 64; o <<= 1) v += __shfl_xor(v, o);
    return v;
}
__device__ __forceinline__ float bf2f(unsigned short b) { return __uint_as_float(((unsigned)b) << 16); }

__device__ __forceinline__ void p0_transpose_item(const float* W, int K, int N, bf16* WT, const float* gain, LAS float* scr, int item, int lane) {
    const int nblk = N / 32, kb = item / nblk, nb = item % nblk, k0 = 64 * kb, n0 = 32 * nb;
#pragma unroll 8
    for (int i = 0; i < 32; ++i) { const int kk = 2 * i + (lane >> 5); float w = W[(size_t)(k0 + kk) * N + n0 + (lane & 31)]; if (gain) w *= gain[k0 + kk]; scr[kk * 33 + (lane & 31)] = w; }
    LDS_WAIT(); asm volatile("" ::: "memory");
    const int c = lane & 7;
#pragma unroll
    for (int j = 0; j < 4; ++j) { const int n = (lane >> 3) + 8 * j; const LAS float* s = scr + (8 * c) * 33 + n;
        v4u o; o.x = pk2(s[0 * 33], s[1 * 33]); o.y = pk2(s[2 * 33], s[3 * 33]); o.z = pk2(s[4 * 33], s[5 * 33]); o.w = pk2(s[6 * 33], s[7 * 33]);
        *(GAS v4u*)(WT + (size_t)(n0 + n) * K + k0 + 8 * c) = o; }
    LDS_WAIT(); asm volatile("" ::: "memory");
}

struct Frame {
    LAS unsigned char* lds;
    int tid, lane, wave, G;
    const float* in[22]; float* out; unsigned char* ws;
};
enum { I_XP = 0, I_XS, I_C128, I_C512, I_C2048, I_ST, I_PP, I_PS, I_GMIX, I_WIN, I_GQ, I_GK, I_LB, I_GHG, I_WUPA, I_WUPH, I_WOUT, I_GFFN, I_WFFU, I_WFFD, I_WPLE, I_WPG };

__device__ __forceinline__ void p0_prologue(Frame& F) {
    LAS float* scr = (LAS float*)(F.lds + RING_OFF + F.wave * 16384);
    const int gw = blockIdx.x * NWAVES + F.wave, NGW = F.G * NWAVES;
    constexpr int I_IN = (DM / 64) * (INW / 32), I_FU = (DM / 64) * (FFH / 32), I_FD = (FFH / 64) * (DM / 32), I_SQ = (DM / 64) * (DM / 32),
                  I_UA = (AW / 64) * (DM / 32), I_UH = (HGW / 64) * (DM / 32), I_PL = (PLED / 64) * (DM / 32);
    constexpr int NITEMS = I_IN + I_FU + I_FD + 2 * I_SQ + I_UA + I_UH + I_PL;
    for (int it = gw; it < NITEMS; it += NGW) {
        int r = it;
        if (r < I_IN) { p0_transpose_item(F.in[I_WIN], DM, INW, (bf16*)(F.ws + WS_WIN), F.in[I_GMIX], scr, r, F.lane); continue; } r -= I_IN;
        if (r < I_FU) { p0_transpose_item(F.in[I_WFFU], DM, FFH, (bf16*)(F.ws + WS_WFFU), F.in[I_GFFN], scr, r, F.lane); continue; } r -= I_FU;
        if (r < I_FD) { p0_transpose_item(F.in[I_WFFD], FFH, DM, (bf16*)(F.ws + WS_WFFD), nullptr, scr, r, F.lane); continue; } r -= I_FD;
        if (r < I_SQ) { p0_transpose_item(F.in[I_WOUT], DM, DM, (bf16*)(F.ws + WS_WOUT), nullptr, scr, r, F.lane); continue; } r -= I_SQ;
        if (r < I_SQ) { p0_transpose_item(F.in[I_WPG], DM, DM, (bf16*)(F.ws + WS_WPG), nullptr, scr, r, F.lane); continue; } r -= I_SQ;
        if (r < I_UA) { p0_transpose_item(F.in[I_WUPA], AW, DM, (bf16*)(F.ws + WS_WUPA), nullptr, scr, r, F.lane); continue; } r -= I_UA;
        if (r < I_UH) { p0_transpose_item(F.in[I_WUPH], HGW, DM, (bf16*)(F.ws + WS_WUPH), nullptr, scr, r, F.lane); continue; } r -= I_UH;
        p0_transpose_item(F.in[I_WPLE], PLED, DM, (bf16*)(F.ws + WS_WPLE), nullptr, scr, r, F.lane);
    }
    for (int m = gw; m < MTOK; m += NGW) {
        const float* xrow = m < TOKP ? F.in[I_XP] + (size_t)m * DM : F.in[I_XS] + (size_t)(m - TOKP) * DM;
        const GAS f32x4* xr = (const GAS f32x4*)xrow + F.lane;
        GAS unsigned long long* o8 = (GAS unsigned long long*)((bf16*)(F.ws + WS_XB) + (size_t)m * DM) + F.lane;
        float s = 0.f;
#pragma unroll 4
        for (int j = 0; j < 16; ++j) { const f32x4 v = xr[64 * j]; s += (v.x * v.x + v.y * v.y) + (v.z * v.z + v.w * v.w);
            o8[64 * j] = (unsigned long long)pk2(v.x, v.y) | ((unsigned long long)pk2(v.z, v.w) << 32); }
        s = wave_sum(s);
        if (F.lane == 0) ((float*)(F.ws + WS_R0))[m] = rsqrtf(s * (1.0f / DM) + 1e-6f);
        const float* prow = m < TOKP ? F.in[I_PP] + (size_t)m * PLED : F.in[I_PS] + (size_t)(m - TOKP) * PLED;
        const f32x4 pv = ((const GAS f32x4*)prow)[F.lane];
        ((GAS unsigned long long*)((bf16*)(F.ws + WS_PB) + (size_t)m * PLED))[F.lane] = (unsigned long long)pk2(pv.x, pv.y) | ((unsigned long long)pk2(pv.z, pv.w) << 32);
    }
}

__device__ __forceinline__ void attn_naive_phase(Frame& F) {
    const bf16* Q = (const bf16*)(F.ws + WS_Q); const bf16* K = (const bf16*)(F.ws + WS_K); const bf16* V = (const bf16*)(F.ws + WS_V);
    bf16* O = (bf16*)(F.ws + WS_OATT);
    const int gw = blockIdx.x * NWAVES + F.wave, NGW = F.G * NWAVES, lane = F.lane;
    for (int it = gw; it < MTOK * 8; it += NGW) {
        const int m = it >> 3, h = it & 7;
        float mx = -1e30f, sum = 0.f, o0 = 0.f, o1 = 0.f;
        for (int g = 0; g < 3; ++g) {
            const int dil = 1 << (2 * g), L = 128 << (2 * g);
            const float slope = exp2f(-8.0f * (float)(g * 8 + h + 1) / 24.0f) * (float)dil;
            const int co = g * 1024 + h * 128 + 2 * lane;
            const unsigned qw = *(const unsigned*)(Q + (size_t)m * 3072 + co);
            const float q0 = __uint_as_float(qw << 16) * 0.08838834764831845f, q1 = __uint_as_float(qw & 0xffff0000u) * 0.08838834764831845f;
            const float* cache = g == 0 ? F.in[I_C128] : (g == 1 ? F.in[I_C512] : F.in[I_C2048]);
            const int b = (m - TOKP) >> 3, t = (m - TOKP) & 7;
            for (int j = 0; j <= 128; ++j) {
                float k0, k1, v0, v1;
                if (m < TOKP) {
                    const int pos = m - dil * j; if (pos < 0) break;
                    const unsigned kw = *(const unsigned*)(K + (size_t)pos * 3072 + co), vw = *(const unsigned*)(V + (size_t)pos * 3072 + co);
                    k0 = __uint_as_float(kw << 16); k1 = __uint_as_float(kw & 0xffff0000u); v0 = __uint_as_float(vw << 16); v1 = __uint_as_float(vw & 0xffff0000u);
                } else {
                    const int idx = L + t - dil * j; if (idx < 0) break;
                    if (idx >= L) {
                        const size_t r = (size_t)(TOKP + b * 8 + (idx - L));
                        const unsigned kw = *(const unsigned*)(K + r * 3072 + co), vw = *(const unsigned*)(V + r * 3072 + co);
                        k0 = __uint_as_float(kw << 16); k1 = __uint_as_float(kw & 0xffff0000u); v0 = __uint_as_float(vw << 16); v1 = __uint_as_float(vw & 0xffff0000u);
                    } else {
                        const float* cr = cache + (((size_t)b * L + idx) * 2) * 1024 + h * 128 + 2 * lane;
                        k0 = cr[0]; k1 = cr[1]; v0 = cr[1024]; v1 = cr[1025];
                    }
                }
                float s = wave_sum(q0 * k0 + q1 * k1) - slope * (float)j;
                const float mn = fmaxf(mx, s), al = __expf(mx - mn), p = __expf(s - mn);
                sum = sum * al + p; o0 = o0 * al + p * v0; o1 = o1 * al + p * v1; mx = mn;
            }
        }
        const float inv = 1.0f / sum;
        *(unsigned*)(O + (size_t)m * 1024 + h * 128 + 2 * lane) = pk2(o0 * inv, o1 * inv);
    }
}

__device__ __forceinline__ void hgrn_naive_phase(Frame& F) {
    const bf16* HQ = (const bf16*)(F.ws + WS_HQ); const bf16* KK = (const bf16*)(F.ws + WS_KK); const bf16* HI = (const bf16*)(F.ws + WS_HI); const bf16* OG = (const bf16*)(F.ws + WS_OG);
    const float* LG = (const float*)(F.ws + WS_LG); bf16* OHG = (bf16*)(F.ws + WS_OHG);
    const float* ghg = F.in[I_GHG];
    LAS float* qs = (LAS float*)(F.lds);
    LAS float* ks = qs + 1024; LAS float* gs = ks + 1024; LAS float* vs = gs + 1024;
    LAS float* part = vs + 1024;
    const int tid = F.tid, v = tid & 127, kq = tid >> 7;
    for (int unit = blockIdx.x; unit < 16 + 512; unit += F.G) {
        int h, row_base, T; float* sout; const float* s0 = nullptr;
        if (unit < 16) { h = unit; row_base = 0; T = TOKP; sout = F.out + pg8::O_STP + (size_t)h * 16384; }
        else { const int b = (unit - 16) >> 4; h = (unit - 16) & 15; row_base = TOKP + b * 8; T = 8; sout = F.out + pg8::O_STS + (size_t)(b * 16 + h) * 16384; s0 = F.in[I_ST] + (size_t)(b * 16 + h) * 16384; }
        float S[32];
#pragma unroll
        for (int i = 0; i < 32; ++i) S[i] = s0 ? s0[(size_t)(32 * kq + i) * 128 + v] : 0.f;
        for (int t0 = 0; t0 < T; t0 += 8) {
            __syncthreads();
#pragma unroll
            for (int e = 0; e < 2; ++e) { const int idx = tid + 512 * e, tt = idx >> 7, k = idx & 127; const size_t off = (size_t)(row_base + t0 + tt) * 2048 + h * 128 + k;
                qs[idx] = bf2f(HQ[off]); ks[idx] = bf2f(KK[off]); gs[idx] = __expf(LG[off]); vs[idx] = bf2f(HI[off]); }
            __syncthreads();
#pragma unroll 1
            for (int tt = 0; tt < 8; ++tt) {
                const float vv = vs[tt * 128 + v]; float po = 0.f;
#pragma unroll
                for (int i = 0; i < 32; ++i) { const int k = 32 * kq + i; S[i] = gs[tt * 128 + k] * S[i] + ks[tt * 128 + k] * vv; po += S[i] * qs[tt * 128 + k]; }
                part[(tt * 4 + kq) * 128 + v] = po;
            }
            __syncthreads();
            {
                const int tt = F.wave, l = F.lane; const size_t ro = (size_t)(row_base + t0 + tt) * 2048 + h * 128;
                const float a0 = part[(tt * 4 + 0) * 128 + 2 * l] + part[(tt * 4 + 1) * 128 + 2 * l] + part[(tt * 4 + 2) * 128 + 2 * l] + part[(tt * 4 + 3) * 128 + 2 * l];
                const float a1 = part[(tt * 4 + 0) * 128 + 2 * l + 1] + part[(tt * 4 + 1) * 128 + 2 * l + 1] + part[(tt * 4 + 2) * 128 + 2 * l + 1] + part[(tt * 4 + 3) * 128 + 2 * l + 1];
                const float rstd = rsqrtf(wave_sum(a0 * a0 + a1 * a1) * (1.0f / 128.0f) + 1e-6f);
                const unsigned ogw = *(const unsigned*)(OG + ro + 2 * l);
                *(unsigned*)(OHG + ro + 2 * l) = pk2(a0 * rstd * ghg[2 * l] * __uint_as_float(ogw << 16), a1 * rstd * ghg[2 * l + 1] * __uint_as_float(ogw & 0xffff0000u));
            }
        }
#pragma unroll
        for (int i = 0; i < 32; ++i) sout[(size_t)(32 * kq + i) * 128 + v] = S[i];
        __syncthreads();
    }
}

__global__ void __launch_bounds__(NWAVES * 64, 2) fwd_kernel(Args args) {
    extern __shared__ __attribute__((aligned(16))) unsigned char lds[];
    Frame F;
    F.lds = (LAS unsigned char*)lds;
    volatile LAS unsigned* MISC = (volatile LAS unsigned*)(F.lds + MISC_OFF);
    F.tid = threadIdx.x; F.lane = F.tid & 63; F.wave = __builtin_amdgcn_readfirstlane(F.tid >> 6); F.G = gridDim.x;
#pragma unroll
    for (int i = 0; i < 22; ++i) F.in[i] = args.in[i];
    F.out = args.out; F.ws = args.ws;
    unsigned char* ws = args.ws;
    gu32* ctl = (gu32*)(ws + WS_CTL);
    for (int u = F.tid; u < 32; u += NWAVES * 64) MISC[u] = 0u;
    __syncthreads();
    XcdBarrier bar = xcd_barrier_post((unsigned*)(ctl + CW_BAR), MISC + 8);
    const int lo = args.ph_lo, hi = args.ph_hi;
#define IN(k) (lo <= (k) && (k) < hi)
#define BOTH(k) (IN(k) && IN((k) + 1))
#define GRID_BAR() xcd_barrier(bar)
    float* ssq = (float*)(ctl + CW_SSQ);
    typedef pg8::bf16_t pb;

    if (IN(0)) { p0_prologue(F); if (BOTH(0)) GRID_BAR(); }

    if (IN(1)) {
        {
            pg8::Gemm g{(const pb*)(ws + WS_XB), (const pb*)(ws + WS_WIN), MTOK, INW, DM}; pg8::StaticOrder S; S.init(MTOK, INW, F.G, (int)blockIdx.x);
            pg8::EpiIn E{(pb*)(ws + WS_Q), (pb*)(ws + WS_K), (pb*)(ws + WS_V), (pb*)(ws + WS_HQ), (pb*)(ws + WS_KK), (pb*)(ws + WS_HI), (pb*)(ws + WS_OG), (pb*)(ws + WS_SA), (pb*)(ws + WS_SB),
                         (float*)(ws + WS_LG), (const float*)(ws + WS_R0), F.in[I_GQ], F.in[I_GK], F.in[I_LB], F.out, (PG8_LAS float*)(F.lds + TAB_OFF)};
            pg8::gemm_phase<pg8::EpiIn, pg8::StaticOrder, true, true>(F.lds + RING_OFF, g, S, E);
        }
        {
            pg8::Gemm g{(const pb*)(ws + WS_PB), (const pb*)(ws + WS_WPLE), MTOK, DM, PLED}; pg8::StaticOrder S; S.init(MTOK, DM, F.G, (int)blockIdx.x);
            pg8::EpiEw<0> E{(pb*)(ws + WS_PP), nullptr, nullptr, nullptr, nullptr, nullptr, nullptr, DM};
            pg8::gemm_phase<pg8::EpiEw<0>, pg8::StaticOrder, true, true>(F.lds + RING_OFF, g, S, E);
        }
        if (BOTH(1)) GRID_BAR();
    }

    if (IN(2)) {
        hgrn_naive_phase(F);
        attn_naive_phase(F);
        if (BOTH(2)) GRID_BAR();
    }

    if (IN(3)) {
        {
            pg8::Gemm g{(const pb*)(ws + WS_OATT), (const pb*)(ws + WS_WUPA), MTOK, DM, AW}; pg8::StaticOrder S; S.init(MTOK, DM, F.G, (int)blockIdx.x);
            pg8::EpiEw<1> E{(pb*)(ws + WS_P1B), (const pb*)(ws + WS_SA), nullptr, nullptr, nullptr, nullptr, nullptr, DM};
            pg8::gemm_phase<pg8::EpiEw<1>, pg8::StaticOrder, true, true>(F.lds + RING_OFF, g, S, E);
        }
        VM_WAIT(); __syncthreads();
        {
            pg8::Gemm g{(const pb*)(ws + WS_OHG), (const pb*)(ws + WS_WUPH), MTOK, DM, HGW}; pg8::StaticOrder S; S.init(MTOK, DM, F.G, (int)blockIdx.x);
            pg8::EpiEw<2> E{(pb*)(ws + WS_MRG), (const pb*)(ws + WS_SB), (const pb*)(ws + WS_P1B), nullptr, nullptr, nullptr, nullptr, DM};
            pg8::gemm_phase<pg8::EpiEw<2>, pg8::StaticOrder, true, true>(F.lds + RING_OFF, g, S, E);
        }
        if (BOTH(3)) GRID_BAR();
    }

    if (IN(4)) {
        pg8::Gemm g{(const pb*)(ws + WS_MRG), (const pb*)(ws + WS_WOUT), MTOK, DM, DM}; pg8::StaticOrder S; S.init(MTOK, DM, F.G, (int)blockIdx.x);
        pg8::EpiEw<3> E{(pb*)(ws + WS_X1B), nullptr, nullptr, F.out, F.in[I_XP], F.in[I_XS], ssq, DM};
        pg8::gemm_phase<pg8::EpiEw<3>, pg8::StaticOrder, true, true>(F.lds + RING_OFF, g, S, E);
        if (BOTH(4)) GRID_BAR();
    }

    if (IN(5)) {
        pg8::Gemm g{(const pb*)(ws + WS_X1B), (const pb*)(ws + WS_WFFU), MTOK, FFH, DM}; pg8::StaticOrder S; S.init(MTOK, FFH, F.G, (int)blockIdx.x);
        pg8::EpiEw<4> E{(pb*)(ws + WS_U), nullptr, nullptr, nullptr, nullptr, nullptr, ssq, FFH};
        pg8::gemm_phase<pg8::EpiEw<4>, pg8::StaticOrder, true, true>(F.lds + RING_OFF, g, S, E);
        if (BOTH(5)) GRID_BAR();
    }

    if (IN(6)) {
        pg8::Gemm g{(const pb*)(ws + WS_U), (const pb*)(ws + WS_WFFD), MTOK, DM, FFH}; pg8::StaticOrder S; S.init(MTOK, DM, F.G, (int)blockIdx.x);
        pg8::EpiEw<5> E{(pb*)(ws + WS_X2B), nullptr, nullptr, F.out, nullptr, nullptr, nullptr, DM};
        pg8::gemm_phase<pg8::EpiEw<5>, pg8::StaticOrder, true, true>(F.lds + RING_OFF, g, S, E);
        if (BOTH(6)) GRID_BAR();
    }

    if (IN(7)) {
        pg8::Gemm g{(const pb*)(ws + WS_X2B), (const pb*)(ws + WS_WPG), MTOK, DM, DM}; pg8::StaticOrder S; S.init(MTOK, DM, F.G, (int)blockIdx.x);
        pg8::EpiEw<6> E{nullptr, (const pb*)(ws + WS_PP), nullptr, F.out, nullptr, nullptr, nullptr, DM};
        pg8::gemm_phase<pg8::EpiEw<6>, pg8::StaticOrder, true, true>(F.lds + RING_OFF, g, S, E);
    }
#undef IN
#undef BOTH
#undef GRID_BAR
}

#ifndef MK_PER_PHASE
#define MK_PER_PHASE 0
#endif
extern "C" void kernel_launch(void* const* d_in, const int* in_sizes, int n_in, void* d_out, int out_size, void* d_ws, size_t ws_size, hipStream_t stream) {
    static int grid = 0;
    if (grid == 0) {
        if (n_in != 22 || out_size != (int)pg8::O_TOTAL || ws_size < WS_END) { fprintf(stderr, "kernel_launch: unexpected shapes (n_in %d out %d ws %zu need %zu)\n", n_in, out_size, ws_size, (size_t)WS_END); grid = -1; return; }
        int dev = 0, cus = 0, per_cu = 0;
        if (hipGetDevice(&dev) != hipSuccess || hipDeviceGetAttribute(&cus, hipDeviceAttributeMultiprocessorCount, dev) != hipSuccess) { grid = -1; return; }
        if (hipFuncSetAttribute((const void*)fwd_kernel, hipFuncAttributeMaxDynamicSharedMemorySize, LDS_BYTES) != hipSuccess) { grid = -1; return; }
        if (hipOccupancyMaxActiveBlocksPerMultiprocessor(&per_cu, (const void*)fwd_kernel, NWAVES * 64, LDS_BYTES) != hipSuccess || per_cu < 1) { fprintf(stderr, "kernel_launch: occupancy query says %d\n", per_cu); }
        (void)hipGetLastError();
        grid = cus;
    }
    if (grid < 0) return;
    if (hipMemsetAsync((char*)d_ws + WS_CTL, 0, CTL_ZERO_BYTES, stream) != hipSuccess) return;
    Args a;
    memset(&a, 0, sizeof(a));
    for (int i = 0; i < 22; ++i) a.in[i] = (const float*)d_in[i];
    a.out = (float*)d_out; a.ws = (unsigned char*)d_ws;
#if MK_PER_PHASE
    for (int p = 0; p < 8; ++p) { a.ph_lo = p; a.ph_hi = p + 1; hipLaunchKernelGGL(fwd_kernel, dim3(grid), dim3(NWAVES * 64), LDS_BYTES, stream, a); }
#else
    a.ph_lo = 0; a.ph_hi = 8;
    hipLaunchKernelGGL(fwd_kernel, dim3(grid), dim3(NWAVES * 64), LDS_BYTES, stream, a);
#endif
}
```

```cpp
#include <hip/hip_runtime.h>
#include <cstdio>
#include <cstdint>
#include <cstring>

namespace pg8 {
#define PG8_LAS __attribute__((address_space(3)))
typedef unsigned short bf16_t;
typedef short bf16x8 __attribute__((ext_vector_type(8)));
typedef float f32x4 __attribute__((ext_vector_type(4)));
typedef unsigned u32x4 __attribute__((ext_vector_type(4)));
typedef int i32x4_t __attribute__((ext_vector_type(4)));
constexpr int BM = 256, BK = 64, HALF = 128, HTB = HALF * BK * 2  , STAGE_BYTES = 8 * HTB, NXCD = 8, WGM = 4;

__host__ __device__ __forceinline__ int lds_byte(int r, int c) { const int st = (r >> 4) * 2 + (c >> 5), rr = r & 15, cc = c & 31, ob = rr * 64 + cc * 2; return st * 1024 + (ob ^ (((ob >> 9) & 1) << 5)); }
__host__ __device__ __forceinline__ void stage_rc(int b, int& R, int& C) { const int st = b / 1024, sb = b % 1024, swz = sb ^ (((sb >> 9) & 1) << 5); R = (st >> 1) * 16 + swz / 64; C = (st & 1) * 32 + (swz % 64) / 2; }
__host__ __device__ __forceinline__ int perm32(int rho) { const int n = rho >> 4, i = rho & 15; return 8 * (i >> 2) + 4 * n + (i & 3); }

struct Unit { int pm, pn, kb, nt; };
struct Gemm { const bf16_t* A; const bf16_t* Bt; int ld; };

struct StaticOrder {
    int nM, nN, nwg, G, c, ntf, wgm;
    __host__ __device__ void init(int M, int N, int K, int G_, int c_, int wgm_ = WGM) { nM = M / BM; nN = N / BM; nwg = nM * nN; G = G_; c = c_; ntf = K / BK; wgm = wgm_; }
    __host__ __device__ bool next(int i, Unit& u) const {
        const long L = (long)i * G + c; if (L >= nwg) return false;
        int wgid = (int)L; { const int q = nwg / NXCD, r = nwg % NXCD, xcd = wgid % NXCD, off = wgid / NXCD; wgid = (xcd < r ? xcd * (q + 1) : r * (q + 1) + (xcd - r) * q) + off; }
        const int nig = wgm * nN, gid = wgid / nig, fm = gid * wgm, gsz = (nM - fm) < wgm ? (nM - fm) : wgm;
        u.pm = fm + ((wgid % nig) % gsz); u.pn = (wgid % nig) / gsz; u.kb = 0; u.nt = ntf; return true;
    }
    __device__ __forceinline__ void a_ready(const Unit&) const {}
    __device__ __forceinline__ void done(const Unit&) const {}
};

struct PanelOrder {
    int nMp, nN, nwg, G, c, ntf, splits, nts, wgm;
    __host__ __device__ void init(int Mp, int N, int K, int G_, int c_, int splits_, int wgm_ = WGM) { wgm = wgm_; nMp = Mp / BM; nN = N / BM; nwg = nMp * nN; G = G_; c = c_; ntf = K / BK; splits = splits_; nts = splits_ ? ntf / splits_ : 0; }
    __host__ __device__ bool next(int i, Unit& u) const {
        const bool pf = (c & 1) && (nwg % G == 0) && (nN * splits <= G);
        int s = -1; long L = (long)i * G + c;
        if (pf) { if (i == 0) { if (c < nN * splits) s = c; else L = c; } else if (c < nN * splits) L = (long)(i - 1) * G + c; }
        if (s < 0) {
            if (L < nwg) {
                int wgid = (int)L; { const int q = nwg / NXCD, r = nwg % NXCD, xcd = wgid % NXCD, off = wgid / NXCD; wgid = (xcd < r ? xcd * (q + 1) : r * (q + 1) + (xcd - r) * q) + off; }
                const int nig = wgm * nN, gid = wgid / nig, fm = gid * wgm, gsz = (nMp - fm) < wgm ? (nMp - fm) : wgm;
                u.pm = fm + ((wgid % nig) % gsz); u.pn = (wgid % nig) / gsz; u.kb = 0; u.nt = ntf; return true;
            }
            if (pf) return false;
            s = (int)(L - nwg); if (s >= nN * splits) return false;
        }
        u.pm = nMp; u.pn = s % nN; u.kb = (s / nN) * nts * BK; u.nt = nts; return true;
    }
    __device__ __forceinline__ void a_ready(const Unit&) const {}
    __device__ __forceinline__ void done(const Unit&) const {}
};

struct TailOrder {
    int nM, nN, nwg, G, c, ntf, n4, lo, hi, wgm;
    __host__ __device__ void init(int M, int N, int K, int G_, int c_, int n4_, int lo_, int hi_, int wgm_ = WGM) { wgm = wgm_; nM = M / BM; nN = N / BM; nwg = nM * nN; G = G_; c = c_; ntf = K / BK; n4 = n4_; lo = lo_; hi = hi_; }
    __host__ __device__ bool next(int i, Unit& u) const {
        long L;
        if (i < n4) L = (long)i * G + c; else if (i == n4 && c >= lo && c < hi) L = (long)n4 * G + (c - lo); else return false;
        if (L >= nwg) return false;
        int wgid = (int)L; { const int q = nwg / NXCD, r = nwg % NXCD, xcd = wgid % NXCD, off = wgid / NXCD; wgid = (xcd < r ? xcd * (q + 1) : r * (q + 1) + (xcd - r) * q) + off; }
        const int nig = wgm * nN, gid = wgid / nig, fm = gid * wgm, gsz = (nM - fm) < wgm ? (nM - fm) : wgm;
        u.pm = fm + ((wgid % nig) % gsz); u.pn = (wgid % nig) / gsz; u.kb = 0; u.nt = ntf; return true;
    }
    __device__ __forceinline__ void a_ready(const Unit&) const {}
    __device__ __forceinline__ void done(const Unit&) const {}
};

struct RangeOrder {
    int nM, nN, nwg, ntf, base, cnt, wgm;
    __host__ __device__ void init(int M, int N, int K, int base_, int cnt_, int wgm_ = WGM) { wgm = wgm_; nM = M / BM; nN = N / BM; nwg = nM * nN; ntf = K / BK; base = base_; cnt = cnt_; }
    __host__ __device__ bool next(int i, Unit& u) const {
        if (i >= cnt || base + i >= nwg) return false;
        int wgid = base + i; { const int q = nwg / NXCD, r = nwg % NXCD, xcd = wgid % NXCD, off = wgid / NXCD; wgid = (xcd < r ? xcd * (q + 1) : r * (q + 1) + (xcd - r) * q) + off; }
        const int nig = wgm * nN, gid = wgid / nig, fm = gid * wgm, gsz = (nM - fm) < wgm ? (nM - fm) : wgm;
        u.pm = fm + ((wgid % nig) % gsz); u.pn = (wgid % nig) / gsz; u.kb = 0; u.nt = ntf; return true;
    }
    __device__ __forceinline__ void a_ready(const Unit&) const {}
    __device__ __forceinline__ void done(const Unit&) const {}
};

__device__ __forceinline__ unsigned cvt_pk_bf16(float lo, float hi) { unsigned r; asm volatile("v_cvt_pk_bf16_f32 %0, %1, %2" : "=v"(r) : "v"(lo), "v"(hi)); return r; }
__device__ __forceinline__ float sigm(float x) { return __builtin_amdgcn_rcpf(1.0f + __expf(-x)); }
__device__ __forceinline__ void st_bf16x8(bf16_t* p, const f32x4 a, const f32x4 b) {
    u32x4 w; w.x = cvt_pk_bf16(a[0], a[1]); w.y = cvt_pk_bf16(a[2], a[3]); w.z = cvt_pk_bf16(b[0], b[1]); w.w = cvt_pk_bf16(b[2], b[3]); *(u32x4*)p = w; }
__device__ __forceinline__ void ld_bf16x8(const bf16_t* p, f32x4& a, f32x4& b) {
    const u32x4 w = *(const u32x4*)p;
    a[0] = __uint_as_float(w.x << 16); a[1] = __uint_as_float(w.x & 0xffff0000u); a[2] = __uint_as_float(w.y << 16); a[3] = __uint_as_float(w.y & 0xffff0000u);
    b[0] = __uint_as_float(w.z << 16); b[1] = __uint_as_float(w.z & 0xffff0000u); b[2] = __uint_as_float(w.w << 16); b[3] = __uint_as_float(w.w & 0xffff0000u); }
__device__ __forceinline__ f32x4 sigm4(const f32x4 v) { f32x4 o; o[0] = sigm(v[0]); o[1] = sigm(v[1]); o[2] = sigm(v[2]); o[3] = sigm(v[3]); return o; }

constexpr int TOK_P = 8192, TOK_ALL = 8448;
constexpr float NEPS = 1e-6f;
constexpr size_t O_Y = 0, O_KV128P = 34603008, O_KV512P = 34865152, O_KV2048P = 35913728, O_STP = 40108032,
                 O_KV128S = 40370176, O_KV512S = 40894464, O_KV2048S = 41418752, O_STS = 41943040, O_TOTAL = 50331648;

__device__ __forceinline__ void kv_store(float* out, int g, int row, int kvsel, int hd, const f32x4 a, const f32x4 b) {
    float* dst;
    if (row >= TOK_P) {
        const size_t base = g == 0 ? O_KV128S : (g == 1 ? O_KV512S : O_KV2048S);
        dst = out + base + ((size_t)(row - TOK_P) * 2 + kvsel) * 1024 + hd;
    } else {
        const int L = 128 << (2 * g);
        if (row < TOK_P - L) return;
        const size_t base = g == 0 ? O_KV128P : (g == 1 ? O_KV512P : O_KV2048P);
        dst = out + base + ((size_t)(row - (TOK_P - L)) * 2 + kvsel) * 1024 + hd;
    }
    *(f32x4*)dst = a; *(f32x4*)(dst + 4) = b;
}

struct EpiIn {
    static constexpr bool PERM = true, AFTER_DRAIN = false;
    bf16_t *Q, *K, *V, *HQ, *KK, *HI, *OG, *SA, *SB; float* LG;
    const float *r0, *gq, *gk, *lbraw; float* out; PG8_LAS float* tab;
    int pn_off; float ascale; int pn_split;
    __device__ __forceinline__ void operator()(const f32x4 (&acc)[2][2][4][2], const Unit& u, int wr, int wc, int fr_, int fq_) const {
        int tz = threadIdx.x; asm volatile("" : "+v"(tz));
        const int fr = tz & 15, fq = (tz >> 4) & 3;
        const int pn = u.pn < pn_split ? u.pn : u.pn + pn_off;
        const int row0 = u.pm * BM + wr * 64 + fr;
        const int cl = wc * 32 + 8 * fq;
        float rsv[2][4];
#pragma unroll
        for (int ai = 0; ai < 2; ++ai)
#pragma unroll
            for (int m = 0; m < 4; ++m) rsv[ai][m] = r0[row0 + ai * HALF + m * 16] * ascale;
        if (pn < 24) {
            const bool isk = pn >= 12;
            const int cb = (isk ? pn - 12 : pn) * 256;
            const float* gain = isk ? gk : gq;
            f32x4 gv[2][2];
#pragma unroll
            for (int bj = 0; bj < 2; ++bj) { const int g = (cb + bj * HALF) >> 10; gv[bj][0] = *(const f32x4*)(gain + g * 128 + cl); gv[bj][1] = *(const f32x4*)(gain + g * 128 + cl + 4); }
            float sq[2][4][2];
#pragma unroll
            for (int ai = 0; ai < 2; ++ai)
#pragma unroll
                for (int m = 0; m < 4; ++m) {
                    const float rs = rsv[ai][m];
#pragma unroll
                    for (int bj = 0; bj < 2; ++bj) {
                        const f32x4 a = acc[ai][bj][m][0] * rs, b = acc[ai][bj][m][1] * rs;
                        sq[ai][m][bj] = (a[0] * a[0] + a[1] * a[1]) + (a[2] * a[2] + a[3] * a[3]) + (b[0] * b[0] + b[1] * b[1]) + (b[2] * b[2] + b[3] * b[3]);
                    }
                }
#pragma unroll
            for (int st = 16; st <= 32; st <<= 1)
#pragma unroll
                for (int ai = 0; ai < 2; ++ai)
#pragma unroll
                    for (int m = 0; m < 4; ++m)
#pragma unroll
                        for (int bj = 0; bj < 2; ++bj) sq[ai][m][bj] += __shfl_xor(sq[ai][m][bj], st);
            if (fq == 0) {
#pragma unroll
                for (int ai = 0; ai < 2; ++ai)
#pragma unroll
                    for (int m = 0; m < 4; ++m)
#pragma unroll
                        for (int bj = 0; bj < 2; ++bj) tab[((ai * HALF + wr * 64 + m * 16 + fr) * 2 + bj) * 4 + wc] = sq[ai][m][bj];
            }
            asm volatile("s_waitcnt lgkmcnt(0)" ::: "memory"); __builtin_amdgcn_s_barrier(); asm volatile("" ::: "memory");
#pragma unroll
            for (int ai = 0; ai < 2; ++ai)
#pragma unroll
                for (int m = 0; m < 4; ++m) {
                    const int row = row0 + ai * HALF + m * 16;
                    const float rs = rsv[ai][m];
#pragma unroll
                    for (int bj = 0; bj < 2; ++bj) {
                        const f32x4 t = *(const PG8_LAS f32x4*)&tab[((ai * HALF + wr * 64 + m * 16 + fr) * 2 + bj) * 4];
                        const float sc = rs * rsqrtf(((t[0] + t[1]) + (t[2] + t[3])) * (1.0f / 128.0f) + NEPS);
                        const int col = cb + bj * HALF + cl;
                        const int g = col >> 10;
                        const f32x4 a = acc[ai][bj][m][0] * sc * gv[bj][0], b = acc[ai][bj][m][1] * sc * gv[bj][1];
                        st_bf16x8((isk ? K : Q) + (size_t)row * 3072 + col, a, b);
                        if (isk) kv_store(out, g, row, 0, col & 1023, a, b);
                    }
                }
            return;
        }
        f32x4 lbv[2][2];
        if (pn >= 44 && pn < 52) {
#pragma unroll
            for (int bj = 0; bj < 2; ++bj)
#pragma unroll
                for (int hf = 0; hf < 2; ++hf) { const int col = (pn - 44) * 256 + bj * HALF + cl + 4 * hf; const f32x4 l0 = *(const f32x4*)(lbraw + col), l1 = *(const f32x4*)(lbraw + 2048 + col);
#pragma unroll
                    for (int j = 0; j < 4; ++j) lbv[bj][hf][j] = __builtin_amdgcn_rcpf(1.0f + __expf(l1[j] - l0[j])); }
        }
#pragma unroll
        for (int ai = 0; ai < 2; ++ai)
#pragma unroll
            for (int m = 0; m < 4; ++m) {
                const int row = row0 + ai * HALF + m * 16;
                const float rs = rsv[ai][m];
#pragma unroll
                for (int bj = 0; bj < 2; ++bj) {
                    f32x4 a = acc[ai][bj][m][0] * rs, b = acc[ai][bj][m][1] * rs;
                    const int ct = bj * HALF + cl;
                    if (pn < 36) {
                        const int col = (pn - 24) * 256 + ct;
                        st_bf16x8(V + (size_t)row * 3072 + col, a, b);
                        kv_store(out, col >> 10, row, 1, col & 1023, a, b);
                    } else if (pn < 44) {
                        const int col = (pn - 36) * 256 + ct;
                        a = a * sigm4(a) * 0.08838834764831845f; b = b * sigm4(b) * 0.08838834764831845f;
                        st_bf16x8(HQ + (size_t)row * 2048 + col, a, b);
                    } else if (pn < 52) {
                        const int col = (pn - 44) * 256 + ct;
                        f32x4 lga, lgb, ka, kb;
#pragma unroll
                        for (int j = 0; j < 4; ++j) {
                            const float lba = lbv[bj][0][j], lbb = lbv[bj][1][j];
                            const float sa_ = sigm(a[j]), sb_ = sigm(b[j]);
                            lga[j] = __logf(lba + (1.0f - lba) * sa_); lgb[j] = __logf(lbb + (1.0f - lbb) * sb_);
                            ka[j] = (1.0f - lba) * sigm(-a[j]); kb[j] = (1.0f - lbb) * sigm(-b[j]);
                        }
                        float* lp = LG + (size_t)row * 2048 + col; *(f32x4*)lp = lga; *(f32x4*)(lp + 4) = lgb;
                        st_bf16x8(KK + (size_t)row * 2048 + col, ka, kb);
                    } else if (pn < 60) {
                        const int col = (pn - 52) * 256 + ct;
                        st_bf16x8(HI + (size_t)row * 2048 + col, a, b);
                    } else if (pn < 68) {
                        const int col = (pn - 60) * 256 + ct;
                        st_bf16x8(OG + (size_t)row * 2048 + col, sigm4(a), sigm4(b));
                    } else if (pn < 84) {
                        const int col = (pn - 68) * 256 + ct;
                        st_bf16x8(SA + (size_t)row * 4096 + col, sigm4(a), sigm4(b));
                    } else {
                        const int col = (pn - 84) * 256 + ct;
                        st_bf16x8(SB + (size_t)row * 4096 + col, sigm4(a), sigm4(b));
                    }
                }
            }
    }
};

template <int KIND> struct EpiEw {
    static constexpr bool PERM = true, AFTER_DRAIN = false;
    bf16_t* O; const bf16_t* G1; const bf16_t* O2; float* F; const float* XP; const float* XS; float* ssq; int ldc;
    unsigned char* O8;
    float* part; int kchunk;
    __device__ __forceinline__ float rowscale(int row) const { return KIND == 4 ? rsqrtf(ssq[row] * (1.0f / 4096.0f) + NEPS) : 0.f; }
    struct Ld { u32x4 g, o2; };
    __device__ __forceinline__ void load8(int row, int col, Ld& L) const {
        const size_t off = (size_t)row * ldc + col;
        if (KIND == 1 || KIND == 2 || KIND == 3 || KIND == 6) L.g = *(const u32x4*)(G1 + off);
        if (KIND == 2 || KIND == 5 || KIND == 6) L.o2 = *(const u32x4*)(O2 + off);
    }
    static __device__ __forceinline__ void unpk(const u32x4 w, f32x4& a, f32x4& b) {
        a[0] = __uint_as_float(w.x << 16); a[1] = __uint_as_float(w.x & 0xffff0000u); a[2] = __uint_as_float(w.y << 16); a[3] = __uint_as_float(w.y & 0xffff0000u);
        b[0] = __uint_as_float(w.z << 16); b[1] = __uint_as_float(w.z & 0xffff0000u); b[2] = __uint_as_float(w.w << 16); b[3] = __uint_as_float(w.w & 0xffff0000u); }
    __device__ __forceinline__ float apply8(int row, int col, f32x4 a, f32x4 b, float rs, const Ld& L) const {
        const size_t off = (size_t)row * ldc + col; float ss = 0.f;
        if (KIND == 0) { st_bf16x8(O + off, a, b); }
        if (KIND == 1) { f32x4 ga, gb; unpk(L.g, ga, gb); st_bf16x8(O + off, a * ga, b * gb); }
        if (KIND == 2) { f32x4 ga, gb, pa, pb; unpk(L.g, ga, gb); unpk(L.o2, pa, pb); st_bf16x8(O + off, pa + a * ga, pb + b * gb); }
        if (KIND == 3) {
            f32x4 xa, xb; unpk(L.g, xa, xb); a += xa; b += xb; st_bf16x8(O + off, a, b);
            ss = (a[0] * a[0] + a[1] * a[1]) + (a[2] * a[2] + a[3] * a[3]) + (b[0] * b[0] + b[1] * b[1]) + (b[2] * b[2] + b[3] * b[3]);
        }
        if (KIND == 4) {
#pragma unroll
            for (int j = 0; j < 4; ++j) { const float x = fmaxf(a[j] * rs, 0.f), y = fmaxf(b[j] * rs, 0.f); a[j] = x * x; b[j] = y * y; }
            st_bf16x8(O + off, a, b);
        }
        if (KIND == 5) { f32x4 xa, xb; unpk(L.o2, xa, xb); a += xa; b += xb; st_bf16x8(O + off, a, b);
            if (O8) { int w0 = __builtin_amdgcn_cvt_pk_fp8_f32(a[0], a[1], 0, false); w0 = __builtin_amdgcn_cvt_pk_fp8_f32(a[2], a[3], w0, true);
                int w1 = __builtin_amdgcn_cvt_pk_fp8_f32(b[0], b[1], 0, false); w1 = __builtin_amdgcn_cvt_pk_fp8_f32(b[2], b[3], w1, true);
                typedef int i32x2_t __attribute__((ext_vector_type(2))); *(i32x2_t*)(O8 + off) = (i32x2_t){w0, w1}; } }
        if (KIND == 6) { f32x4 ga, gb, xa, xb; unpk(L.g, ga, gb); unpk(L.o2, xa, xb); a = xa + sigm4(a * 0.015625f) * ga; b = xb + sigm4(b * 0.015625f) * gb;
            *(f32x4*)(F + off) = a; *(f32x4*)(F + off + 4) = b; }
        return ss;
    }
    __device__ __forceinline__ void operator()(const f32x4 (&acc)[2][2][4][2], const Unit& u, int wr, int wc, int fr_, int fq_) const {
        int tz = threadIdx.x; asm volatile("" : "+v"(tz));
        const int fr = tz & 15, fq = (tz >> 4) & 3;
        const int row0 = u.pm * BM + wr * 64 + fr;
        const int col0 = u.pn * BM + wc * 32 + 8 * fq;
        if (part != nullptr && u.pm == TOK_P / BM) {
            float* pb = part + ((size_t)(u.kb / kchunk) * 256 + (row0 - TOK_P)) * ldc + col0;
#pragma unroll
            for (int ai = 0; ai < 2; ++ai)
#pragma unroll
                for (int m = 0; m < 4; ++m)
#pragma unroll
                    for (int bj = 0; bj < 2; ++bj) { float* p = pb + (size_t)(ai * HALF + m * 16) * ldc + bj * HALF; *(f32x4*)p = acc[ai][bj][m][0]; *(f32x4*)(p + 4) = acc[ai][bj][m][1]; }
            return;
        }
        float rsv[2][4];
        if (KIND == 4) {
#pragma unroll
            for (int ai = 0; ai < 2; ++ai)
#pragma unroll
                for (int m = 0; m < 4; ++m) rsv[ai][m] = ssq[row0 + ai * HALF + m * 16];
        }
        constexpr int MB = (KIND == 6) ? 1 : 2, NB = 8 / MB;
        Ld L[2][MB][2];
#define EPI_LOAD(B_) do { _Pragma("unroll") for (int mm = 0; mm < MB; ++mm) { const int q_ = (B_) * MB + mm; _Pragma("unroll") for (int bj = 0; bj < 2; ++bj) \
            load8(row0 + (q_ >> 2) * HALF + (q_ & 3) * 16, col0 + bj * HALF, L[(B_) & 1][mm][bj]); } } while (0)
        EPI_LOAD(0);
#pragma unroll
        for (int bt = 0; bt < NB; ++bt) {
            if (bt + 1 < NB) EPI_LOAD(bt + 1);
#pragma unroll
            for (int mm = 0; mm < MB; ++mm) {
                const int q = bt * MB + mm, ai = q >> 2, m = q & 3, row = row0 + ai * HALF + m * 16;
                const float rs = KIND == 4 ? rsqrtf(rsv[ai][m] * (1.0f / 4096.0f) + NEPS) : 0.f;
                float ss = 0.f;
#pragma unroll
                for (int bj = 0; bj < 2; ++bj) ss += apply8(row, col0 + bj * HALF, acc[ai][bj][m][0], acc[ai][bj][m][1], rs, L[bt & 1][mm][bj]);
                if (KIND == 3) { ss += __shfl_xor(ss, 16); ss += __shfl_xor(ss, 32); if (fq == 0) atomicAdd(ssq + row, ss); }
            }
        }
#undef EPI_LOAD
    }
    __device__ __forceinline__ void finalize(int nsplit, int gtid, int gthreads) const {
        const int per_row = ldc / 8;
        for (int it = gtid; it < 256 * per_row; it += gthreads) {
            const int rs_ = it / per_row, c8 = it - rs_ * per_row;
            f32x4 a = {0.f, 0.f, 0.f, 0.f}, b = a;
            for (int sp = 0; sp < nsplit; ++sp) { const float* p = part + ((size_t)sp * 256 + rs_) * ldc + c8 * 8; a += *(const f32x4*)p; b += *(const f32x4*)(p + 4); }
            const int row = TOK_P + rs_;
            Ld L; load8(row, c8 * 8, L);
            float ss = apply8(row, c8 * 8, a, b, rowscale(row), L);
            if (KIND == 3) {
#pragma unroll
                for (int o = 1; o < 64; o <<= 1) ss += __shfl_xor(ss, o);
                if ((threadIdx.x & 63) == 0) atomicAdd(ssq + row, ss);
            }
        }
    }
};

struct EpiNull {
    static constexpr bool PERM = true, AFTER_DRAIN = false;
    __device__ __forceinline__ void operator()(const f32x4 (&acc)[2][2][4][2], const Unit& u, int wr, int wc, int fr, int fq) const {
#pragma unroll
        for (int ai = 0; ai < 2; ++ai)
#pragma unroll
            for (int bj = 0; bj < 2; ++bj)
#pragma unroll
                for (int m = 0; m < 4; ++m) { asm volatile("" :: "v"(acc[ai][bj][m][0]), "v"(acc[ai][bj][m][1])); }
    }
};

template <class Epi, class Sched, bool ALIGN_EPI = false, bool SP2 = false, bool F8 = false>
__device__ __forceinline__ void gemm_phase(PG8_LAS unsigned char* lds, const Gemm g, const Sched& S, const Epi& E) {
    const int tid = threadIdx.x, wid = __builtin_amdgcn_readfirstlane(tid >> 6), lane = tid & 63, wr = wid >> 2, wc = wid & 3, fr = lane & 15, fq = lane >> 4;
    const int K = g.ld;
    unsigned voffA[2], voffB[2];
#pragma unroll
    for (int i = 0; i < 2; ++i) { int R, C; stage_rc(tid * 16 + i * 8192, R, C); const int Rb = Epi::PERM ? ((R & ~31) + perm32(R & 31)) : R;
        voffA[i] = (unsigned)(R * K + C) * 2u; voffB[i] = (unsigned)(Rb * K + C) * 2u; }
    const size_t kstep = (size_t)(BK * 2);
    const size_t hstep = (size_t)HALF * K * 2;
    const size_t tstep = 2 * hstep;
    const unsigned ldsw = (unsigned)wid * 1024u;
    const int aoff = lds_byte(wr * 64 + fr, fq * 8), boff = lds_byte(wc * 32 + fr, fq * 8);
#define PG8_SA(b, h) (((b) * 2 + (h)) * HTB)
#define PG8_SB(b, h) ((4 + (b) * 2 + (h)) * HTB)
#define PG8_STAGE(bufoff, gbase, voff) do { _Pragma("unroll") for (int _i = 0; _i < 2; ++_i) \
        __builtin_amdgcn_global_load_lds((const unsigned*)((const char*)(gbase) + (voff)[_i]), (PG8_LAS unsigned*)(lds + (bufoff) + ldsw + _i * 8192), 16, 0, 0); } while (0)
#define PG8_LDA(dst, b, h) do { _Pragma("unroll") for (int m = 0; m < 4; ++m) _Pragma("unroll") for (int k = 0; k < 2; ++k) dst[m][k] = *(const PG8_LAS bf16x8*)(lds + PG8_SA(b, h) + aoff + m * 2048 + k * 1024); } while (0)
#define PG8_LDB(dst, b, h) do { _Pragma("unroll") for (int n = 0; n < 2; ++n) _Pragma("unroll") for (int k = 0; k < 2; ++k) dst[n][k] = *(const PG8_LAS bf16x8*)(lds + PG8_SB(b, h) + boff + n * 2048 + k * 1024); } while (0)
#define PG8_MMA(ai, bj, At, Bt) do { __builtin_amdgcn_s_setprio(1); _Pragma("unroll") for (int m = 0; m < 4; ++m) _Pragma("unroll") for (int n = 0; n < 2; ++n) { \
        if constexpr (F8) { asm volatile("v_mfma_scale_f32_16x16x128_f8f6f4 %0, %1, %2, %0, %3, %3 op_sel_hi:[0,0,0]" : "+v"(acc[ai][bj][m][n]) \
                : "v"(__builtin_shufflevector(__builtin_bit_cast(i32x4_t, Bt[n][0]), __builtin_bit_cast(i32x4_t, Bt[n][1]), 0, 1, 2, 3, 4, 5, 6, 7)), \
                  "v"(__builtin_shufflevector(__builtin_bit_cast(i32x4_t, At[m][0]), __builtin_bit_cast(i32x4_t, At[m][1]), 0, 1, 2, 3, 4, 5, 6, 7)), "v"(f8scale)); } \
        else { _Pragma("unroll") for (int k = 0; k < 2; ++k) acc[ai][bj][m][n] = __builtin_amdgcn_mfma_f32_16x16x32_bf16(Bt[n][k], At[m][k], acc[ai][bj][m][n], 0, 0, 0); } } \
        __builtin_amdgcn_s_setprio(0); } while (0)
#define PG8_WAIT_V(n) asm volatile("s_waitcnt vmcnt(" #n ")" ::: "memory")
#define PG8_WAIT_L(n) asm volatile("s_waitcnt lgkmcnt(" #n ")" ::: "memory")
#define PG8_BAR __builtin_amdgcn_s_barrier()
#define PG8_SCHED __builtin_amdgcn_sched_barrier(0)
    Unit cur, nxt; int ui = 0;
    if (!S.next(0, cur)) return;
    f32x4 acc[2][2][4][2];
#pragma unroll
    for (int a = 0; a < 2; ++a)
#pragma unroll
        for (int b = 0; b < 2; ++b)
#pragma unroll
            for (int m = 0; m < 4; ++m)
#pragma unroll
                for (int n = 0; n < 2; ++n) acc[a][b][m][n] = (f32x4){0.f, 0.f, 0.f, 0.f};
    bf16x8 At[4][2], B0[2][2], B1[2][2];
    const int f8scale = 0x7f7f7f7f;
    int nt = cur.nt;
    const char* cA = (const char*)g.A + (size_t)cur.pm * tstep + (size_t)cur.kb * 2; const char* cB = (const char*)g.Bt + (size_t)cur.pn * tstep + (size_t)cur.kb * 2;
    S.a_ready(cur);
    if constexpr (SP2) {
        PG8_STAGE(PG8_SB(0, 0), cB, voffB); PG8_STAGE(PG8_SB(0, 1), cB + hstep, voffB); PG8_STAGE(PG8_SA(0, 0), cA, voffA); PG8_STAGE(PG8_SA(0, 1), cA + hstep, voffA);
        if (wr == 1) PG8_BAR;
        PG8_WAIT_V(2); PG8_BAR;
        PG8_STAGE(PG8_SB(1, 0), cB + kstep, voffB); PG8_STAGE(PG8_SA(1, 0), cA + kstep, voffA); PG8_STAGE(PG8_SB(1, 1), cB + hstep + kstep, voffB);
        PG8_WAIT_V(6); PG8_BAR;
    } else {
        PG8_STAGE(PG8_SB(0, 0), cB, voffB); PG8_STAGE(PG8_SA(0, 0), cA, voffA); PG8_STAGE(PG8_SB(0, 1), cB + hstep, voffB); PG8_STAGE(PG8_SA(0, 1), cA + hstep, voffA);
        if (wr == 1) PG8_BAR;
        PG8_WAIT_V(4); PG8_BAR;
        PG8_STAGE(PG8_SB(1, 0), cB + kstep, voffB); PG8_STAGE(PG8_SA(1, 0), cA + kstep, voffA); PG8_STAGE(PG8_SB(1, 1), cB + hstep + kstep, voffB);
        PG8_WAIT_V(6); PG8_BAR;
    }
    for (;;) {
        const bool has_next = S.next(ui + 1, nxt);
        const char* nA = has_next ? (const char*)g.A + (size_t)nxt.pm * tstep + (size_t)nxt.kb * 2 : cA; const char* nB = has_next ? (const char*)g.Bt + (size_t)nxt.pn * tstep + (size_t)nxt.kb * 2 : cB;
        for (int t = 0; t < nt; t += 2) {
            const bool last = (t == nt - 2);
            const char* a1 = cA + (size_t)(t + 1) * kstep;
            const char* a2 = last ? nA : cA + (size_t)(t + 2) * kstep; const char* b2 = last ? nB : cB + (size_t)(t + 2) * kstep;
            const char* a3 = a2 + kstep; const char* b3 = b2 + kstep;
            if (last && has_next) S.a_ready(nxt);
            if constexpr (SP2) {
            PG8_LDB(B0, 0, 0); PG8_LDB(B1, 0, 1); PG8_SCHED; PG8_LDA(At, 0, 0); PG8_STAGE(PG8_SA(1, 1), a1 + hstep, voffA);
            PG8_WAIT_V(8); PG8_WAIT_L(0); PG8_BAR; PG8_MMA(0, 0, At, B0); PG8_MMA(0, 1, At, B1); PG8_BAR; PG8_SCHED;
            PG8_LDA(At, 0, 1); PG8_STAGE(PG8_SB(0, 0), b2, voffB); PG8_STAGE(PG8_SB(0, 1), b2 + hstep, voffB); PG8_STAGE(PG8_SA(0, 0), a2, voffA);
            PG8_WAIT_V(8); PG8_WAIT_L(0); PG8_BAR; PG8_MMA(1, 0, At, B0); PG8_MMA(1, 1, At, B1); PG8_BAR; PG8_SCHED;
            PG8_LDB(B0, 1, 0); PG8_LDB(B1, 1, 1); PG8_SCHED; PG8_LDA(At, 1, 0); PG8_STAGE(PG8_SA(0, 1), a2 + hstep, voffA);
            PG8_WAIT_V(8); PG8_WAIT_L(0); PG8_BAR; PG8_MMA(0, 0, At, B0); PG8_MMA(0, 1, At, B1); PG8_BAR; PG8_SCHED;
            PG8_LDA(At, 1, 1); PG8_STAGE(PG8_SB(1, 0), b3, voffB); PG8_STAGE(PG8_SB(1, 1), b3 + hstep, voffB); PG8_STAGE(PG8_SA(1, 0), a3, voffA);
            PG8_WAIT_V(8); PG8_WAIT_L(0); PG8_BAR; PG8_MMA(1, 0, At, B0); PG8_MMA(1, 1, At, B1); PG8_BAR; PG8_SCHED;
            } else {
            PG8_LDB(B0, 0, 0); PG8_SCHED; PG8_LDA(At, 0, 0); PG8_STAGE(PG8_SA(1, 1), a1 + hstep, voffA);
            PG8_WAIT_L(8); PG8_BAR; PG8_WAIT_L(0); PG8_MMA(0, 0, At, B0); PG8_BAR; PG8_SCHED;
            PG8_LDB(B1, 0, 1); PG8_STAGE(PG8_SB(0, 0), b2, voffB);
            PG8_BAR; PG8_WAIT_L(0); PG8_MMA(0, 1, At, B1); PG8_BAR;
            PG8_LDA(At, 0, 1); PG8_STAGE(PG8_SA(0, 0), a2, voffA);
            PG8_BAR; PG8_WAIT_L(0); PG8_MMA(1, 0, At, B0); PG8_BAR; PG8_SCHED;
            PG8_STAGE(PG8_SB(0, 1), b2 + hstep, voffB);
            PG8_WAIT_V(6); PG8_BAR; PG8_MMA(1, 1, At, B1); PG8_BAR;
            PG8_LDB(B0, 1, 0); PG8_SCHED; PG8_LDA(At, 1, 0); PG8_STAGE(PG8_SA(0, 1), a2 + hstep, voffA);
            PG8_WAIT_L(8); PG8_BAR; PG8_WAIT_L(0); PG8_MMA(0, 0, At, B0); PG8_BAR; PG8_SCHED;
            PG8_LDB(B1, 1, 1); PG8_STAGE(PG8_SB(1, 0), b3, voffB);
            PG8_BAR; PG8_WAIT_L(0); PG8_MMA(0, 1, At, B1); PG8_BAR;
            PG8_LDA(At, 1, 1); PG8_STAGE(PG8_SA(1, 0), a3, voffA);
            PG8_BAR; PG8_WAIT_L(0); PG8_MMA(1, 0, At, B0); PG8_BAR; PG8_SCHED;
            PG8_STAGE(PG8_SB(1, 1), b3 + hstep, voffB);
            PG8_WAIT_V(6); PG8_BAR; PG8_MMA(1, 1, At, B1); PG8_BAR;
            }
        }
        if constexpr (ALIGN_EPI) { if (wr == 0) PG8_BAR; }
        if constexpr (F8) asm volatile("s_nop 15\n\ts_nop 15" ::: "memory");
        if constexpr (!Epi::AFTER_DRAIN) { E(acc, cur, wr, wc, fr, fq); S.done(cur); }
        if (!has_next) break;
#pragma unroll
        for (int a = 0; a < 2; ++a)
#pragma unroll
            for (int b = 0; b < 2; ++b)
#pragma unroll
                for (int m = 0; m < 4; ++m)
#pragma unroll
                    for (int n = 0; n < 2; ++n) acc[a][b][m][n] = (f32x4){0.f, 0.f, 0.f, 0.f};
        cur = nxt; cA = nA; cB = nB; ++ui; nt = cur.nt;
        if constexpr (ALIGN_EPI) { if (wr == 1) PG8_BAR; }
    }
    PG8_WAIT_V(0);
    if constexpr (!ALIGN_EPI) { if (wr == 0) PG8_BAR; }
    PG8_BAR;
    if constexpr (Epi::AFTER_DRAIN) { E.fused(acc, cur, wr, wc, fr, fq, lds, wid, lane); S.done(cur); }
#undef PG8_SA
#undef PG8_SB
#undef PG8_STAGE
#undef PG8_LDA
#undef PG8_LDB
#undef PG8_MMA
#undef PG8_WAIT_V
#undef PG8_WAIT_L
#undef PG8_BAR
#undef PG8_SCHED
}
}

#define GAS __attribute__((address_space(1)))
#define LAS __attribute__((address_space(3)))
typedef unsigned short bf16;
typedef unsigned v4u __attribute__((ext_vector_type(4)));
typedef float f32x4 __attribute__((ext_vector_type(4)));
typedef short bf16x8 __attribute__((ext_vector_type(8)));
typedef GAS unsigned gu32;
typedef GAS unsigned long long gu64;
#define RLX_AGENT __ATOMIC_RELAXED, __HIP_MEMORY_SCOPE_AGENT
#define LDS_WAIT() asm volatile("s_waitcnt lgkmcnt(0)" ::: "memory")
#define VM_WAIT() asm volatile("s_waitcnt vmcnt(0)" ::: "memory")
__device__ __forceinline__ unsigned long long rt() { return __builtin_amdgcn_s_memrealtime(); }
__device__ __forceinline__ unsigned f2bf(float f) { unsigned u = __builtin_bit_cast(unsigned, f); return (u + 0x7fffu + ((u >> 16) & 1u)) >> 16; }
__device__ __forceinline__ unsigned pk2(float lo, float hi) { unsigned r; asm volatile("v_cvt_pk_bf16_f32 %0, %1, %2" : "=v"(r) : "v"(lo), "v"(hi)); return r; }

#define XB_TMO      128
#define XB_XCNT(j)  (256  + 64 * (j))
#define XB_XSUB(j)  (1280 + 64 * (j))
#define XB_XGEN(j)  (2304 + 64 * (j))
#define XB_TOP      3328
#define XB_TOPGEN   3392
#define XCD_BAR_WORDS 3456
#define XB_SPIN_CAP (1u << 18)

__device__ __forceinline__ unsigned xb_ld(unsigned* p)              { return __hip_atomic_load(p, __ATOMIC_RELAXED, __HIP_MEMORY_SCOPE_AGENT); }
__device__ __forceinline__ unsigned xb_add(unsigned* p, unsigned v) { return __hip_atomic_fetch_add(p, v, __ATOMIC_RELAXED, __HIP_MEMORY_SCOPE_AGENT); }
__device__ __forceinline__ unsigned xb_xcc_id() { return (unsigned)__builtin_amdgcn_s_getreg((3 << 11) | 20) & 0xFu; }
#define XB_SPIN(cond, bar) do { unsigned _sp = 0; while (cond) { __builtin_amdgcn_s_sleep(1); \
    if ((++_sp & 255u) == 0u) { if (xb_ld(&(bar)[XB_TMO])) break; if (_sp > XB_SPIN_CAP) { atomicAdd(&(bar)[XB_TMO], 1u); break; } } } } while (0)

struct XcdBarrier {
    unsigned* bar; unsigned x;
    volatile LAS unsigned* st;
};

__device__ __forceinline__ XcdBarrier xcd_barrier_post(unsigned* bar, volatile LAS unsigned* st) {
    XcdBarrier b; b.bar = bar; b.x = xb_xcc_id(); b.st = st;
    if (threadIdx.x == 0) (void)xb_add(&bar[XB_XCNT(b.x)], 1u);
    return b;
}
__device__ __forceinline__ void xcd_barrier_complete(unsigned* bar, unsigned x, unsigned& nloc, unsigned& nx) {
    const unsigned G = gridDim.x * gridDim.y * gridDim.z;
    unsigned sum, cnt, mine, sp = 0u;
    for (;;) {
        sum = 0u; cnt = 0u; mine = 0u;
#pragma unroll
        for (unsigned j = 0; j < 16; ++j) { const unsigned c = xb_ld(&bar[XB_XCNT(j)]); sum += c; cnt += (c > 0u) ? 1u : 0u; mine = (j == x) ? c : mine; }
        if (sum == G) break;
        __builtin_amdgcn_s_sleep(1);
        if ((++sp & 255u) == 0u) { if (xb_ld(&bar[XB_TMO])) break; if (sp > XB_SPIN_CAP) { atomicAdd(&bar[XB_TMO], 1u); break; } }
    }
    nloc = mine > 0u ? mine : 1u; nx = cnt > 0u ? cnt : 1u;
}

__device__ __forceinline__ void xcd_barrier(const XcdBarrier& b) {
    asm volatile("s_waitcnt vmcnt(0)" ::: "memory");
    __syncthreads();
    if (threadIdx.x == 0) {
        unsigned* bar = b.bar;
        __builtin_amdgcn_s_waitcnt(0);
        unsigned nloc = b.st[0], nx = b.st[1];
        if (nloc == 0u) { xcd_barrier_complete(bar, b.x, nloc, nx); b.st[0] = nloc; b.st[1] = nx; }
        const unsigned old = xb_add(&bar[XB_XSUB(b.x)], 1u);
        const unsigned gen = old / nloc;
        if (old + 1u == (gen + 1u) * nloc) {
            __builtin_amdgcn_fence(__ATOMIC_RELEASE, "agent");
            asm volatile("s_waitcnt vmcnt(0)" ::: "memory");
            const unsigned og = xb_add(&bar[XB_TOP], 1u);
            const unsigned tg = og / nx;
            if (og + 1u == (tg + 1u) * nx) xb_add(&bar[XB_TOPGEN], 1u);
            else XB_SPIN(xb_ld(&bar[XB_TOPGEN]) == tg, bar);
            __builtin_amdgcn_fence(__ATOMIC_ACQUIRE, "agent");
            xb_add(&bar[XB_XGEN(b.x)], 1u);
            asm volatile("s_waitcnt vmcnt(0)" ::: "memory");
        } else {
            XB_SPIN(xb_ld(&bar[XB_XGEN(b.x)]) == gen, bar);
            __builtin_amdgcn_fence(__ATOMIC_ACQUIRE, "agent");
            asm volatile("s_waitcnt vmcnt(0)" ::: "memory");
        }
    }
    __syncthreads();
}

constexpr int NWAVES = 8;
constexpr int DM = 4096, TOKP = 8192, TOKS = 256, MTOK = TOKP + TOKS, INW = 25600, FFH = 16384, PLED = 256;
constexpr int AW = 1024, HGW = 2048;
constexpr size_t al256(size_t x) { return (x + 255) & ~(size_t)255; }
constexpr size_t WS_CTL = 0, CTL_ZERO_BYTES = 128u << 10;
constexpr size_t WS_WIN   = CTL_ZERO_BYTES;
constexpr size_t WS_WFFU  = WS_WIN  + (size_t)INW * DM * 2;
constexpr size_t WS_WFFD  = WS_WFFU + (size_t)FFH * DM * 2;
constexpr size_t WS_WOUT  = WS_WFFD + (size_t)DM * FFH * 2;
constexpr size_t WS_WPG   = WS_WOUT + (size_t)DM * DM * 2;
constexpr size_t WS_WUPA  = WS_WPG  + (size_t)DM * DM * 2;
constexpr size_t WS_WUPH  = WS_WUPA + (size_t)DM * AW * 2;
constexpr size_t WS_WPLE  = WS_WUPH + (size_t)DM * HGW * 2;
constexpr size_t WS_XB    = WS_WPLE + (size_t)DM * PLED * 2;
constexpr size_t WS_R0    = WS_XB   + (size_t)MTOK * DM * 2;
constexpr size_t WS_PB    = al256(WS_R0 + (size_t)MTOK * 4);
constexpr size_t WS_Q     = WS_PB   + (size_t)MTOK * PLED * 2;
constexpr size_t WS_K     = WS_Q    + (size_t)MTOK * 3072 * 2;
constexpr size_t WS_V     = WS_K    + (size_t)MTOK * 3072 * 2;
constexpr size_t WS_HQ    = WS_V    + (size_t)MTOK * 3072 * 2;
constexpr size_t WS_KK    = WS_HQ   + (size_t)MTOK * HGW * 2;
constexpr size_t WS_HI    = WS_KK   + (size_t)MTOK * HGW * 2;
constexpr size_t WS_OG    = WS_HI   + (size_t)MTOK * HGW * 2;
constexpr size_t WS_LG    = WS_OG   + (size_t)MTOK * HGW * 2;
constexpr size_t WS_SA    = WS_LG   + (size_t)MTOK * HGW * 4;
constexpr size_t WS_SB    = WS_SA   + (size_t)MTOK * DM * 2;
constexpr size_t WS_PP    = WS_SB   + (size_t)MTOK * DM * 2;
constexpr size_t WS_OATT  = WS_PP   + (size_t)MTOK * DM * 2;
constexpr size_t WS_OHG   = WS_OATT + (size_t)MTOK * AW * 2;
constexpr size_t WS_P1B   = WS_OHG  + (size_t)MTOK * HGW * 2;
constexpr size_t WS_MRG   = WS_P1B  + (size_t)MTOK * DM * 2;
constexpr size_t WS_X1B   = WS_MRG  + (size_t)MTOK * DM * 2;
constexpr size_t WS_X2B   = WS_X1B  + (size_t)MTOK * DM * 2;
constexpr size_t WS_U     = WS_X2B  + (size_t)MTOK * DM * 2;
constexpr size_t WS_OGA   = WS_U    + (size_t)MTOK * FFH * 2;
constexpr size_t WS_LSE   = WS_OGA  + (size_t)3 * MTOK * AW * 2;
constexpr size_t WS_SST   = WS_LSE  + (size_t)3 * MTOK * 8 * 4;
constexpr size_t WS_DSC   = WS_SST  + (size_t)16 * 32 * 16384 * 4;
constexpr size_t WS_PART  = WS_DSC  + (size_t)16 * 32 * 128 * 4;
constexpr size_t WS_X2F8  = WS_PART + (size_t)16 * 256 * 4096 * 4;
constexpr size_t WS_XF8   = WS_X2F8 + (size_t)MTOK * DM;
constexpr size_t WS_END   = WS_XF8  + (size_t)MTOK * DM;
constexpr int IN16_LO = 3072, IN16_N = 12288, IN8_Q = 3072, IN8_G = 10240;
constexpr size_t WS_WIN8  = WS_WIN + (size_t)IN16_N * DM * 2;
static_assert(WS_WIN8 + (size_t)(IN8_Q + IN8_G) * DM <= WS_WFFU, "w_in copies");
static_assert(WS_END <= 2147483648ull, "workspace");
constexpr int CW_BAR = 4096;
constexpr int CW_SSQ = 16384;
static_assert((CW_SSQ + MTOK) * 4 <= (int)CTL_ZERO_BYTES && CW_BAR + XCD_BAR_WORDS <= CW_SSQ, "CTL map");
constexpr int RING_OFF = 0, RING_BYTES = 131072;
constexpr int TAB_OFF = RING_BYTES;
constexpr int MISC_OFF = 147456;
constexpr int PTAB_OFF = MISC_OFF + 256;
constexpr int LDS_BYTES = 155648;
static_assert(MISC_OFF + 128 <= LDS_BYTES, "LDS map");

struct Args {
    const float* in[22]; float* out; unsigned char* ws; int ph_lo, ph_hi;
};
static_assert(sizeof(Args) == 22 * 8 + 8 + 8 + 8, "no padding");

__device__ __forceinline__ float wave_sum(float v) {
#pragma unroll
    for (int o = 1; o < 64; o <<= 1) v += __shfl_xor(v, o);
    return v;
}
__device__ __forceinline__ float bf2f(unsigned short b) { return __uint_as_float(((unsigned)b) << 16); }

struct P0Item { const float* src; const float* gain; unsigned char* dst; int N, K, f8; };
__device__ __forceinline__ void p0_item_load(const P0Item& d, f32x4 (&v)[16], int lane) {
    const int lr = lane >> 4, lc = lane & 15;
#pragma unroll
    for (int i = 0; i < 16; ++i) v[i] = *(const GAS f32x4*)(d.src + (size_t)(4 * i + lr) * d.N + 4 * lc);
}
__device__ __forceinline__ void p0_item_store(const P0Item& d, const f32x4 (&v)[16], LAS float* scr, int lane) {
    const int lr = lane >> 4, lc = lane & 15;
    const int c = lane & 7, r = lane >> 3;
    f32x4 g0 = {1.f, 1.f, 1.f, 1.f}, g1 = g0;
    if (d.gain) { g0 = *(const GAS f32x4*)(d.gain + 8 * c); g1 = *(const GAS f32x4*)(d.gain + 8 * c + 4); }
    if (d.f8) { g0 = g0 * 64.f; g1 = g1 * 64.f; }
#pragma unroll
    for (int i = 0; i < 16; ++i) { LAS float* p = scr + (4 * i + lr) * 65 + 4 * lc; p[0] = v[i].x; p[1] = v[i].y; p[2] = v[i].z; p[3] = v[i].w; }
    LDS_WAIT(); asm volatile("" ::: "memory");
    if (d.f8) {
#pragma unroll
        for (int j = 0; j < 8; ++j) { const int n = 8 * j + r; const LAS float* s = scr + (8 * c) * 65 + n;
            int w0 = __builtin_amdgcn_cvt_pk_fp8_f32(s[0 * 65] * g0[0], s[1 * 65] * g0[1], 0, false); w0 = __builtin_amdgcn_cvt_pk_fp8_f32(s[2 * 65] * g0[2], s[3 * 65] * g0[3], w0, true);
            int w1 = __builtin_amdgcn_cvt_pk_fp8_f32(s[4 * 65] * g1[0], s[5 * 65] * g1[1], 0, false); w1 = __builtin_amdgcn_cvt_pk_fp8_f32(s[6 * 65] * g1[2], s[7 * 65] * g1[3], w1, true);
            typedef int i32x2_t __attribute__((ext_vector_type(2)));
            *(GAS i32x2_t*)(d.dst + (size_t)n * d.K + 8 * c) = (i32x2_t){w0, w1}; }
    } else {
#pragma unroll
        for (int j = 0; j < 8; ++j) { const int n = 8 * j + r; const LAS float* s = scr + (8 * c) * 65 + n;
            v4u o; o.x = pk2(s[0 * 65] * g0[0], s[1 * 65] * g0[1]); o.y = pk2(s[2 * 65] * g0[2], s[3 * 65] * g0[3]); o.z = pk2(s[4 * 65] * g1[0], s[5 * 65] * g1[1]); o.w = pk2(s[6 * 65] * g1[2], s[7 * 65] * g1[3]);
            *(GAS v4u*)(d.dst + ((size_t)n * d.K + 8 * c) * 2) = o; }
    }
    LDS_WAIT(); asm volatile("" ::: "memory");
}

struct Frame {
    LAS unsigned char* lds;
    int tid, lane, wave, G;
    float* out; unsigned char* ws;
};
enum { I_XP = 0, I_XS, I_C128, I_C512, I_C2048, I_ST, I_PP, I_PS, I_GMIX, I_WIN, I_GQ, I_GK, I_LB, I_GHG, I_WUPA, I_WUPH, I_WOUT, I_GFFN, I_WFFU, I_WFFD, I_WPLE, I_WPG };

constexpr int P0_I_IN = (DM / 64) * (IN16_N / 64), P0_I_IN8Q = (DM / 64) * (IN8_Q / 64), P0_I_IN8G = (DM / 64) * (IN8_G / 64), P0_I_IN8 = P0_I_IN8Q + P0_I_IN8G, P0_I_PL = (PLED / 64) * (DM / 64), P0_I_FU = (DM / 64) * (FFH / 64), P0_I_FD = (FFH / 64) * (DM / 64),
              P0_I_SQ = (DM / 64) * (DM / 64), P0_I_UA = (AW / 64) * (DM / 64), P0_I_UH = (HGW / 64) * (DM / 64);
constexpr int P0_NITEMS = P0_I_IN + P0_I_IN8 + P0_I_PL + P0_I_FU + P0_I_FD + 2 * P0_I_SQ + P0_I_UA + P0_I_UH;
#ifndef P0_DEF1_V
#define P0_DEF1_V 24
#endif
#ifndef P0_DEF1B_V
#define P0_DEF1B_V 120
#endif
constexpr int P0_SL_LO = 48, P0_SL_HI = 228;
constexpr int P0_DEF1 = P0_DEF1_V, P0_DEF1B = P0_DEF1B_V, P0_NDEF1 = (P0_SL_HI - P0_SL_LO) * P0_DEF1 + (256 - P0_SL_HI) * P0_DEF1B;
constexpr int P0_DEF2 = 80, P0_NDEF2 = (192 + 128) * P0_DEF2, P0_NDEF = P0_NDEF1 + P0_NDEF2;
static_assert(P0_NITEMS - P0_NDEF >= P0_I_IN + P0_I_IN8 + P0_I_PL, "copies the input-projection phase itself reads must not be deferred into it");
static_assert(P0_NITEMS - P0_NDEF2 >= P0_I_IN + P0_I_IN8 + P0_I_PL + P0_I_UA + P0_I_UH, "copies the up-projection phase reads must not be deferred into it");
__device__ __forceinline__ void p0_items(Frame& F, const Args& A, const int first, const int last, const int w0, const int stride) {
    LAS float* scr = (LAS float*)(F.lds + RING_OFF + F.wave * 16640);
    unsigned char* wsb = F.ws;
    LAS unsigned long long* ptab = (LAS unsigned long long*)(F.lds + PTAB_OFF);
    if (F.tid == 0) {
        ptab[0] = (unsigned long long)A.in[I_WIN];  ptab[1] = (unsigned long long)A.in[I_GMIX];
        ptab[2] = (unsigned long long)A.in[I_WIN];  ptab[3] = (unsigned long long)A.in[I_GMIX];
        ptab[4] = (unsigned long long)A.in[I_WIN];  ptab[5] = (unsigned long long)A.in[I_GMIX];
        ptab[6] = (unsigned long long)A.in[I_WPLE]; ptab[7] = 0ull;
        ptab[8] = (unsigned long long)A.in[I_WUPA]; ptab[9] = 0ull;
        ptab[10] = (unsigned long long)A.in[I_WUPH]; ptab[11] = 0ull;
        ptab[12] = (unsigned long long)A.in[I_WOUT]; ptab[13] = 0ull;
        ptab[14] = (unsigned long long)A.in[I_WPG]; ptab[15] = 0ull;
        ptab[16] = (unsigned long long)A.in[I_WFFU]; ptab[17] = (unsigned long long)A.in[I_GFFN];
        ptab[18] = (unsigned long long)A.in[I_WFFD]; ptab[19] = 0ull;
    }
    __syncthreads();
#define P0_DESC(IT, D) do { int r_ = (IT); int mi_; size_t o_; int K_, Nc_, N_, f8_ = 0, cb_ = 0; \
        if (r_ < P0_I_IN) { mi_ = 0; o_ = WS_WIN; K_ = DM; Nc_ = IN16_N; N_ = INW; cb_ = IN16_LO; } \
        else if ((r_ -= P0_I_IN) < P0_I_IN8Q) { mi_ = 1; o_ = WS_WIN8; K_ = DM; Nc_ = IN8_Q; N_ = INW; f8_ = 1; cb_ = 0; } \
        else if ((r_ -= P0_I_IN8Q) < P0_I_IN8G) { mi_ = 2; o_ = WS_WIN8 + (size_t)IN8_Q * DM; K_ = DM; Nc_ = IN8_G; N_ = INW; f8_ = 1; cb_ = 15360; } \
        else if ((r_ -= P0_I_IN8G) < P0_I_PL) { mi_ = 3; o_ = WS_WPLE; K_ = PLED; Nc_ = DM; N_ = DM; } \
        else if ((r_ -= P0_I_PL) < P0_I_UA) { mi_ = 4; o_ = WS_WUPA; K_ = AW; Nc_ = DM; N_ = DM; } \
        else if ((r_ -= P0_I_UA) < P0_I_UH) { mi_ = 5; o_ = WS_WUPH; K_ = HGW; Nc_ = DM; N_ = DM; } \
        else if ((r_ -= P0_I_UH) < P0_I_SQ) { mi_ = 6; o_ = WS_WOUT; K_ = DM; Nc_ = DM; N_ = DM; } \
        else if ((r_ -= P0_I_SQ) < P0_I_SQ) { mi_ = 7; o_ = WS_WPG; K_ = DM; Nc_ = DM; N_ = DM; f8_ = 1; } \
        else if ((r_ -= P0_I_SQ) < P0_I_FU) { mi_ = 8; o_ = WS_WFFU; K_ = DM; Nc_ = FFH; N_ = FFH; } \
        else { r_ -= P0_I_FU; mi_ = 9; o_ = WS_WFFD; K_ = FFH; Nc_ = DM; N_ = DM; } \
        const float* W_ = (const float*)ptab[2 * mi_]; const float* g_ = (const float*)ptab[2 * mi_ + 1]; \
        const int nblk_ = Nc_ / 64, kb_ = r_ / nblk_, nb_ = r_ - kb_ * nblk_; \
        (D).src = W_ + (size_t)(64 * kb_) * N_ + cb_ + 64 * nb_; (D).gain = g_ ? g_ + 64 * kb_ : nullptr; (D).N = N_; (D).K = K_; (D).f8 = f8_; \
        (D).dst = wsb + o_ + ((size_t)(64 * nb_) * K_ + 64 * kb_) * (f8_ ? 1 : 2); } while (0)
    {
        P0Item d0, d1; f32x4 va[16], vb[16];
        int it = first + w0;
        if (it < last) { P0_DESC(it, d0); p0_item_load(d0, va, F.lane); }
        while (it < last) {
            int it2 = it + stride;
            if (it2 < last) { P0_DESC(it2, d1); p0_item_load(d1, vb, F.lane); }
            p0_item_store(d0, va, scr, F.lane);
            it = it2; if (it >= last) break;
            it2 = it + stride;
            if (it2 < last) { P0_DESC(it2, d0); p0_item_load(d0, va, F.lane); }
            p0_item_store(d1, vb, scr, F.lane);
            it = it2;
        }
    }
#undef P0_DESC
}
__device__ __forceinline__ void p0_prologue(Frame& F, const Args& A) {
    const int gw = blockIdx.x * NWAVES + F.wave, NGW = F.G * NWAVES;
    p0_items(F, A, 0, P0_NITEMS - (F.G == 256 ? P0_NDEF : 0), gw, NGW);
    for (int m = gw; m < MTOK; m += NGW) {
        const float* xrow = m < TOKP ? A.in[I_XP] + (size_t)m * DM : A.in[I_XS] + (size_t)(m - TOKP) * DM;
        const GAS f32x4* xr = (const GAS f32x4*)xrow + F.lane;
        GAS unsigned long long* o8 = (GAS unsigned long long*)((bf16*)(F.ws + WS_XB) + (size_t)m * DM) + F.lane;
        float s = 0.f;
        f32x4 xv[16];
#pragma unroll
        for (int j = 0; j < 16; ++j) xv[j] = xr[64 * j];
#pragma unroll
        for (int j = 0; j < 16; ++j) { const f32x4 v = xv[j]; s += (v.x * v.x + v.y * v.y) + (v.z * v.z + v.w * v.w);
            o8[64 * j] = (unsigned long long)pk2(v.x, v.y) | ((unsigned long long)pk2(v.z, v.w) << 32);
            { int w8 = __builtin_amdgcn_cvt_pk_fp8_f32(v.x, v.y, 0, false); w8 = __builtin_amdgcn_cvt_pk_fp8_f32(v.z, v.w, w8, true); ((GAS int*)(F.ws + WS_XF8 + (size_t)m * DM))[F.lane + 64 * j] = w8; } }
        s = wave_sum(s);
        if (F.lane == 0) ((float*)(F.ws + WS_R0))[m] = rsqrtf(s * (1.0f / DM) + 1e-6f);
        const float* prow = m < TOKP ? A.in[I_PP] + (size_t)m * PLED : A.in[I_PS] + (size_t)(m - TOKP) * PLED;
        const f32x4 pv = ((const GAS f32x4*)prow)[F.lane];
        ((GAS unsigned long long*)((bf16*)(F.ws + WS_PB) + (size_t)m * PLED))[F.lane] = (unsigned long long)pk2(pv.x, pv.y) | ((unsigned long long)pk2(pv.z, pv.w) << 32);
    }
}

__device__ __forceinline__ void attn_naive_phase(Frame& F, const Args& A) {
    const bf16* Q = (const bf16*)(F.ws + WS_Q); const bf16* K = (const bf16*)(F.ws + WS_K); const bf16* V = (const bf16*)(F.ws + WS_V);
    bf16* O = (bf16*)(F.ws + WS_OATT);
    const int gw = blockIdx.x * NWAVES + F.wave, NGW = F.G * NWAVES, lane = F.lane;
    for (int it = gw; it < MTOK * 8; it += NGW) {
        const int m = it >> 3, h = it & 7;
        float mx = -1e30f, sum = 0.f, o0 = 0.f, o1 = 0.f;
        for (int g = 0; g < 3; ++g) {
            const int dil = 1 << (2 * g), L = 128 << (2 * g);
            const float slope = exp2f(-8.0f * (float)(g * 8 + h + 1) / 24.0f) * (float)dil;
            const int co = g * 1024 + h * 128 + 2 * lane;
            const unsigned qw = *(const unsigned*)(Q + (size_t)m * 3072 + co);
            const float q0 = __uint_as_float(qw << 16) * 0.08838834764831845f, q1 = __uint_as_float(qw & 0xffff0000u) * 0.08838834764831845f;
            const float* cache = A.in[I_C128 + g];
            const int b = (m - TOKP) >> 3, t = (m - TOKP) & 7;
            for (int j = 0; j <= 128; ++j) {
                float k0, k1, v0, v1;
                if (m < TOKP) {
                    const int pos = m - dil * j; if (pos < 0) break;
                    const unsigned kw = *(const unsigned*)(K + (size_t)pos * 3072 + co), vw = *(const unsigned*)(V + (size_t)pos * 3072 + co);
                    k0 = __uint_as_float(kw << 16); k1 = __uint_as_float(kw & 0xffff0000u); v0 = __uint_as_float(vw << 16); v1 = __uint_as_float(vw & 0xffff0000u);
                } else {
                    const int idx = L + t - dil * j; if (idx < 0) break;
                    if (idx >= L) {
                        const size_t r = (size_t)(TOKP + b * 8 + (idx - L));
                        const unsigned kw = *(const unsigned*)(K + r * 3072 + co), vw = *(const unsigned*)(V + r * 3072 + co);
                        k0 = __uint_as_float(kw << 16); k1 = __uint_as_float(kw & 0xffff0000u); v0 = __uint_as_float(vw << 16); v1 = __uint_as_float(vw & 0xffff0000u);
                    } else {
                        const float* cr = cache + (((size_t)b * L + idx) * 2) * 1024 + h * 128 + 2 * lane;
                        k0 = cr[0]; k1 = cr[1]; v0 = cr[1024]; v1 = cr[1025];
                    }
                }
                float s = wave_sum(q0 * k0 + q1 * k1) - slope * (float)j;
                const float mn = fmaxf(mx, s), al = __expf(mx - mn), p = __expf(s - mn);
                sum = sum * al + p; o0 = o0 * al + p * v0; o1 = o1 * al + p * v1; mx = mn;
            }
        }
        const float inv = 1.0f / sum;
        *(unsigned*)(O + (size_t)m * 1024 + h * 128 + 2 * lane) = pk2(o0 * inv, o1 * inv);
    }
}

typedef short s16x4 __attribute__((ext_vector_type(4)));
constexpr int ATT_KS = 272, ATT_VS = 288;
constexpr int ATT_K_OFF = 0, ATT_V_OFF = 256 * ATT_KS;
static_assert(ATT_V_OFF + 256 * ATT_VS <= MISC_OFF, "attention LDS map");
template <int OFF> __device__ __forceinline__ s16x4 tr_read(unsigned vb) {
    s16x4 r; asm volatile("ds_read_b64_tr_b16 %0, %1 offset:%2" : "=&v"(r) : "v"(vb), "i"(OFF) : "memory"); return r;
}
#define MFMA16(a, b, c) __builtin_amdgcn_mfma_f32_16x16x32_bf16((a), (b), (c), 0, 0, 0)
template <int DT> __device__ __forceinline__ void att_pv_one(f32x4& od, unsigned vb, const bf16x8 (&P)[5]) {
    constexpr int TS = 16 * ATT_VS;
    const s16x4 a0 = tr_read<0 * TS + DT * 32>(vb), a1 = tr_read<1 * TS + DT * 32>(vb), a2 = tr_read<2 * TS + DT * 32>(vb), a3 = tr_read<3 * TS + DT * 32>(vb), a4 = tr_read<4 * TS + DT * 32>(vb);
    const s16x4 a5 = tr_read<5 * TS + DT * 32>(vb), a6 = tr_read<6 * TS + DT * 32>(vb), a7 = tr_read<7 * TS + DT * 32>(vb), a8 = tr_read<8 * TS + DT * 32>(vb), a9 = tr_read<9 * TS + DT * 32>(vb);
    asm volatile("s_waitcnt lgkmcnt(0)" ::: "memory"); __builtin_amdgcn_sched_barrier(0);
#define PK8(L, H) (bf16x8){L[0], L[1], L[2], L[3], H[0], H[1], H[2], H[3]}
    od = MFMA16(PK8(a0, a1), P[0], od); od = MFMA16(PK8(a2, a3), P[1], od); od = MFMA16(PK8(a4, a5), P[2], od); od = MFMA16(PK8(a6, a7), P[3], od); od = MFMA16(PK8(a8, a9), P[4], od);
#undef PK8
}
__device__ __forceinline__ unsigned cvtpk(float lo, float hi) { unsigned r; asm volatile("v_cvt_pk_bf16_f32 %0, %1, %2" : "=v"(r) : "v"(lo), "v"(hi)); return r; }

__device__ __forceinline__ void attn_prompt_phase(Frame& F, const Args& A) {
    const bf16* Q = (const bf16*)(F.ws + WS_Q); const bf16* K = (const bf16*)(F.ws + WS_K); const bf16* V = (const bf16*)(F.ws + WS_V);
    bf16* OGA = (bf16*)(F.ws + WS_OGA); float* LSE = (float*)(F.ws + WS_LSE);
    const int tid = F.tid, lane = F.lane, w = F.wave, l15 = lane & 15, kq = lane >> 4;
    const unsigned ldsb = (unsigned)(size_t)F.lds;
#define ATT_BAR() do { asm volatile("s_waitcnt lgkmcnt(0)" ::: "memory"); __builtin_amdgcn_s_barrier(); asm volatile("" ::: "memory"); } while (0)
    v4u kreg[8], vreg[8];
#define ATT_PREFETCH(U) do { const int g_ = (U) >> 9, rem_ = (U) & 511, h_ = rem_ >> 6, c_ = rem_ & 63, dil_ = 1 << (2 * g_), sh_ = 6 - 2 * g_, z_ = c_ >> sh_, n_ = c_ & ((1 << sh_) - 1); \
        const size_t colb_ = (size_t)g_ * 1024 + h_ * 128; \
        _Pragma("unroll") for (int e = 0; e < 8; ++e) { const int j_ = (tid >> 4) + 32 * e, u_ = 128 * (n_ - 1) + j_; \
            kreg[e] = (v4u){0u, 0u, 0u, 0u}; vreg[e] = (v4u){0u, 0u, 0u, 0u}; \
            if (u_ >= 0) { const size_t off_ = (size_t)(u_ * dil_ + z_) * 3072 + colb_ + (tid & 15) * 8; kreg[e] = *(const GAS v4u*)(K + off_); vreg[e] = *(const GAS v4u*)(V + off_); } } } while (0)
    if ((int)blockIdx.x < 1536) ATT_PREFETCH((int)blockIdx.x);
    for (int unit = blockIdx.x; unit < 1536; unit += F.G) {
        const int g = unit >> 9, rem = unit & 511, h = rem >> 6, c = rem & 63;
        const int dil = 1 << (2 * g), sh = 6 - 2 * g, z = c >> sh, n = c & ((1 << sh) - 1);
        const size_t colb = (size_t)g * 1024 + h * 128;
        ATT_BAR();
#pragma unroll
        for (int e = 0; e < 8; ++e) { const int j = (tid >> 4) + 32 * e, ch = tid & 15;
            *(LAS v4u*)(F.lds + ATT_K_OFF + j * ATT_KS + ch * 16) = kreg[e]; *(LAS v4u*)(F.lds + ATT_V_OFF + j * ATT_VS + ch * 16) = vreg[e]; }
        const int tokq = (128 * n + 16 * w + l15) * dil + z;
        bf16x8 qf[4];
#pragma unroll
        for (int ks = 0; ks < 4; ++ks) qf[ks] = *(const GAS bf16x8*)(Q + (size_t)tokq * 3072 + colb + 32 * ks + 8 * kq);
        if (unit + F.G < 1536) ATT_PREFETCH(unit + F.G);
        ATT_BAR();
        const int ts = w & ~1;
        f32x4 T[10];
#pragma unroll
        for (int ti = 0; ti < 10; ++ti) {
            T[ti] = (f32x4){0.f, 0.f, 0.f, 0.f};
#pragma unroll
            for (int ks = 0; ks < 4; ++ks) {
                const bf16x8 a = *(const LAS bf16x8*)(F.lds + ATT_K_OFF + (16 * (ts + ti) + l15) * ATT_KS + (32 * ks + 8 * kq) * 2);
                T[ti] = MFMA16(a, qf[ks], T[ti]);
            }
        }
        const float c1 = 0.08838834764831845f * 1.4426950408889634f;
        const float cs = exp2f(-8.0f * (float)(g * 8 + h + 1) / 24.0f) * (float)dil * 1.4426950408889634f;
        const int i = 16 * w + l15;
        float mx = -__builtin_inff();
#pragma unroll
        for (int ti = 0; ti < 10; ++ti)
#pragma unroll
            for (int r = 0; r < 4; ++r) {
                const int j = 16 * (ts + ti) + 4 * kq + r, delta = 128 + i - j;
                const bool valid = ((unsigned)delta <= 128u) && (n > 0 || j >= 128);
                const float v = valid ? T[ti][r] * c1 - cs * (float)delta : -__builtin_inff();
                T[ti][r] = v; mx = fmaxf(mx, v);
            }
        mx = fmaxf(mx, __shfl_xor(mx, 16)); mx = fmaxf(mx, __shfl_xor(mx, 32));
        float sum = 0.f;
#pragma unroll
        for (int ti = 0; ti < 10; ++ti)
#pragma unroll
            for (int r = 0; r < 4; ++r) { const float p = __builtin_amdgcn_exp2f(T[ti][r] - mx); T[ti][r] = p; sum += p; }
        sum += __shfl_xor(sum, 16); sum += __shfl_xor(sum, 32);
        bf16x8 P[5];
#pragma unroll
        for (int p = 0; p < 5; ++p) { v4u wv; wv.x = cvtpk(T[2 * p][0], T[2 * p][1]); wv.y = cvtpk(T[2 * p][2], T[2 * p][3]); wv.z = cvtpk(T[2 * p + 1][0], T[2 * p + 1][1]); wv.w = cvtpk(T[2 * p + 1][2], T[2 * p + 1][3]);
            P[p] = __builtin_bit_cast(bf16x8, wv); }
        const unsigned vb = ldsb + ATT_V_OFF + (16 * ts + 4 * kq + (l15 >> 2)) * ATT_VS + (l15 & 3) * 8;
        f32x4 O[8];
#pragma unroll
        for (int dt = 0; dt < 8; ++dt) O[dt] = (f32x4){0.f, 0.f, 0.f, 0.f};
        att_pv_one<0>(O[0], vb, P); att_pv_one<1>(O[1], vb, P); att_pv_one<2>(O[2], vb, P); att_pv_one<3>(O[3], vb, P);
        att_pv_one<4>(O[4], vb, P); att_pv_one<5>(O[5], vb, P); att_pv_one<6>(O[6], vb, P); att_pv_one<7>(O[7], vb, P);
        const float inv = 1.0f / sum;
        bf16* orow = OGA + ((size_t)g * MTOK + tokq) * 1024 + h * 128 + 4 * kq;
#pragma unroll
        for (int dt = 0; dt < 8; ++dt) {
            const unsigned long long pk = (unsigned long long)cvtpk(O[dt][0] * inv, O[dt][1] * inv) | ((unsigned long long)cvtpk(O[dt][2] * inv, O[dt][3] * inv) << 32);
            *(GAS unsigned long long*)(orow + 16 * dt) = pk;
        }
        if (kq == 0) LSE[((size_t)g * MTOK + tokq) * 8 + h] = mx + __log2f(sum);
    }
}

__device__ __forceinline__ void attn_sample_phase(Frame& F, const Args& A) {
    const bf16* Q = (const bf16*)(F.ws + WS_Q);
    bf16* OGA = (bf16*)(F.ws + WS_OGA); float* LSE = (float*)(F.ws + WS_LSE);
    LAS float* qs = (LAS float*)(F.lds + F.wave * 1280);
    LAS float* ps = qs + 128;
    const int gw = blockIdx.x * NWAVES + F.wave, NGW = F.G * NWAVES, lane = F.lane;
    for (int it = gw; it < 6144; it += NGW) {
        const int g = it >> 11, r = it & 2047, t = r & 7, h = (r >> 3) & 7, b = r >> 6, ms = b * 8 + t;
        const int dil = 1 << (2 * g), L = 128 << (2 * g);
        const float* cache = A.in[I_C128 + g] + (size_t)b * L * 2048 + h * 128;
        const float* newr = F.out + (g == 0 ? pg8::O_KV128S : (g == 1 ? pg8::O_KV512S : pg8::O_KV2048S)) + (size_t)b * 8 * 2048 + h * 128;
        const float c1 = 0.08838834764831845f * 1.4426950408889634f;
        const float cs = exp2f(-8.0f * (float)(g * 8 + h + 1) / 24.0f) * (float)dil * 1.4426950408889634f;
        const size_t row = (size_t)(TOKP + ms);
        { const unsigned qw = *(const unsigned*)(Q + row * 3072 + g * 1024 + h * 128 + 2 * lane);
          qs[2 * lane] = __uint_as_float(qw << 16) * c1; qs[2 * lane + 1] = __uint_as_float(qw & 0xffff0000u) * c1; }
        const float NEG = -__builtin_inff();
        {
            const int rsub = lane >> 5, dq = lane & 31;
            const f32x4 q4 = *(const LAS f32x4*)(qs + 4 * dq);
            for (int i0 = 0; i0 < 66; i0 += 22) {
                f32x4 kv[22];
#pragma unroll
                for (int u = 0; u < 22; ++u) {
                    const int j = 2 * (i0 + u) + rsub, idx = L + t - dil * j; const int ic = (idx >= 0 && j <= 128) ? idx : 0;
                    kv[u] = *(const f32x4*)((ic < L ? cache + (size_t)ic * 2048 : newr + (size_t)(ic - L) * 2048) + 4 * dq);
                }
                float sv[22];
#pragma unroll
                for (int u = 0; u < 22; ++u) sv[u] = (q4[0] * kv[u][0] + q4[1] * kv[u][1]) + (q4[2] * kv[u][2] + q4[3] * kv[u][3]);
#pragma unroll
                for (int st = 1; st < 32; st <<= 1) {
#pragma unroll
                    for (int u = 0; u < 22; ++u) sv[u] += __shfl_xor(sv[u], st);
                }
#pragma unroll
                for (int u = 0; u < 22; ++u) {
                    const int j = 2 * (i0 + u) + rsub, idx = L + t - dil * j; const bool valid = idx >= 0 && j <= 128;
                    if (dq == 0) ps[j] = valid ? sv[u] - cs * (float)j : NEG;
                }
            }
        }
        const int iC = L + t - dil * 128, cC = iC < 0 ? 0 : iC;
        const float* pC = cC < L ? cache + (size_t)cC * 2048 : newr + (size_t)(cC - L) * 2048;
        const int jA = lane, jB = lane + 64;
        const float sA = ps[jA], sB = ps[jB], sC = ps[128];
        float mx = fmaxf(fmaxf(sA, sB), sC);
#pragma unroll
        for (int o = 1; o < 64; o <<= 1) mx = fmaxf(mx, __shfl_xor(mx, o));
        const float eA = __builtin_amdgcn_exp2f(sA - mx), eB = __builtin_amdgcn_exp2f(sB - mx), eC = __builtin_amdgcn_exp2f(sC - mx);
        const float sum = wave_sum(eA + eB) + eC;
        ps[jA] = eA; ps[jB] = eB; if (lane == 0) ps[128] = eC;
        const int js = lane >> 4, dq = lane & 15;
        f32x4 o0 = {0.f, 0.f, 0.f, 0.f}, o1 = o0;
#pragma unroll 16
        for (int i = 0; i < 32; ++i) {
            const int j = js + 4 * i, idx = L + t - dil * j, ic = idx < 0 ? 0 : idx;
            const float pj = idx < 0 ? 0.f : ps[j];
            const float* vr = (ic < L ? cache + (size_t)ic * 2048 : newr + (size_t)(ic - L) * 2048) + 1024 + 8 * dq;
            const f32x4 v0 = *(const f32x4*)vr, v1 = *(const f32x4*)(vr + 4);
            o0 += v0 * pj; o1 += v1 * pj;
        }
        if (iC >= 0 && js == 0) { const float* vr = pC + 1024 + 8 * dq; const f32x4 v0 = *(const f32x4*)vr, v1 = *(const f32x4*)(vr + 4); o0 += v0 * eC; o1 += v1 * eC; }
#pragma unroll
        for (int st = 16; st <= 32; st <<= 1) {
#pragma unroll
            for (int c = 0; c < 4; ++c) { o0[c] += __shfl_xor(o0[c], st); o1[c] += __shfl_xor(o1[c], st); } }
        const float inv = 1.0f / sum;
        if (js == 0) pg8::st_bf16x8(OGA + ((size_t)g * MTOK + row) * 1024 + h * 128 + 8 * dq, o0 * inv, o1 * inv);
        if (lane == 0) LSE[((size_t)g * MTOK + row) * 8 + h] = mx + __log2f(sum);
    }
}

__device__ __forceinline__ void attn_merge_phase(Frame& F, const Args& A) {
    const bf16* OGA = (const bf16*)(F.ws + WS_OGA); const float* LSE = (const float*)(F.ws + WS_LSE); bf16* O = (bf16*)(F.ws + WS_OATT);
    const int stride = F.G * NWAVES * 64;
    for (int it0 = blockIdx.x * (NWAVES * 64) + F.tid; it0 < MTOK * 128; it0 += 4 * stride) {
        v4u og[4][3]; float ls[4][3];
#pragma unroll
        for (int u = 0; u < 4; ++u) { const int it = it0 + u * stride; if (it < MTOK * 128) { const int row = it >> 7, c8 = it & 127, h = c8 >> 4;
#pragma unroll
            for (int g = 0; g < 3; ++g) { ls[u][g] = LSE[((size_t)g * MTOK + row) * 8 + h]; og[u][g] = *(const GAS v4u*)(OGA + ((size_t)g * MTOK + row) * 1024 + c8 * 8); } } }
#pragma unroll
        for (int u = 0; u < 4; ++u) { const int it = it0 + u * stride; if (it < MTOK * 128) { const int row = it >> 7, c8 = it & 127;
            const float mm = fmaxf(fmaxf(ls[u][0], ls[u][1]), ls[u][2]);
            float w0 = __builtin_amdgcn_exp2f(ls[u][0] - mm), w1 = __builtin_amdgcn_exp2f(ls[u][1] - mm), w2 = __builtin_amdgcn_exp2f(ls[u][2] - mm);
            const float inv = 1.0f / (w0 + w1 + w2); w0 *= inv; w1 *= inv; w2 *= inv;
            f32x4 a0, b0, a1, b1, a2, b2;
            pg8::EpiEw<0>::unpk(og[u][0], a0, b0); pg8::EpiEw<0>::unpk(og[u][1], a1, b1); pg8::EpiEw<0>::unpk(og[u][2], a2, b2);
            pg8::st_bf16x8(O + (size_t)row * 1024 + c8 * 8, a0 * w0 + a1 * w1 + a2 * w2, b0 * w0 + b1 * w1 + b2 * w2); } }
    }
}

typedef float f32x2v __attribute__((ext_vector_type(2)));
typedef unsigned u32x2v __attribute__((ext_vector_type(2)));
constexpr int HG_QD = 0, HG_KD = 8704, HG_KET = 17408, HG_VS = 27648, HG_DV = 36864, HG_PT = 37376, HG_OB = 41472, HG_END = 58368;
constexpr int HG_RS = 272, HG_KES = 80, HG_VSS = 288, HG_OBS = 528;
static_assert(HG_END <= MISC_OFF, "hgrn LDS map");
struct HgPre { float l0[4], l1[4]; unsigned kk[4], q[4]; v4u v, og; };
#define HG_BAR() do { asm volatile("s_waitcnt lgkmcnt(0)" ::: "memory"); __builtin_amdgcn_s_barrier(); asm volatile("" ::: "memory"); } while (0)
template <bool FULL>
__device__ __forceinline__ void hg_prefetch(Frame& F, HgPre& P, const size_t row0, const int nvalid, const int h) {
    const bf16* HQ = (const bf16*)(F.ws + WS_HQ); const bf16* KK = (const bf16*)(F.ws + WS_KK); const bf16* HI = (const bf16*)(F.ws + WS_HI); const float* LG = (const float*)(F.ws + WS_LG);
    const int k0 = 2 * F.lane, part = F.wave;
#pragma unroll
    for (int tt = 0; tt < 4; ++tt) {
        const int t = 4 * part + tt; const size_t off = (row0 + t) * 2048 + h * 128 + k0;
        P.l0[tt] = 0.f; P.l1[tt] = 0.f; P.kk[tt] = 0u; P.q[tt] = 0u;
        if (t < nvalid) { const f32x2v lv = *(const GAS f32x2v*)(LG + off); P.l0[tt] = lv.x; P.l1[tt] = lv.y; P.kk[tt] = *(const GAS unsigned*)(KK + off); if (FULL) P.q[tt] = *(const GAS unsigned*)(HQ + off); }
    }
    const int s = F.tid >> 4, ch = F.tid & 15;
    P.v = (v4u){0u, 0u, 0u, 0u}; P.og = (v4u){0u, 0u, 0u, 0u};
    if (s < nvalid) { P.v = *(const GAS v4u*)(HI + (row0 + s) * 2048 + h * 128 + ch * 8);
        if (FULL) P.og = *(const GAS v4u*)((const bf16*)(F.ws + WS_OG) + (row0 + s) * 2048 + h * 128 + ch * 8); }
}
template <bool FULL>
__device__ __forceinline__ void hgrn_chunk(Frame& F, f32x4 (&S)[8], float& bs0, float& bs1, HgPre& P, const size_t row0, const int nvalid, const int h, const float* ghg,
                                           const bool has_next, const size_t row0_next, const int nvalid_next, const f32x4 w0 = (f32x4){0.f, 0.f, 0.f, 0.f}, const f32x4 w1 = (f32x4){0.f, 0.f, 0.f, 0.f}) {
    const bf16* HQ = (const bf16*)(F.ws + WS_HQ); const bf16* KK = (const bf16*)(F.ws + WS_KK); const bf16* HI = (const bf16*)(F.ws + WS_HI); const bf16* OG = (const bf16*)(F.ws + WS_OG);
    const float* LG = (const float*)(F.ws + WS_LG); bf16* OHG = (bf16*)(F.ws + WS_OHG);
    const int tid = F.tid, lane = F.lane, w = F.wave, l15 = lane & 15, kq = lane >> 4;
    LAS unsigned char* lds = F.lds;
    const int kp = lane, part = w, k0 = 2 * kp;
    float c0[4], c1[4]; unsigned kkw[4], qw[4]; v4u og_cur;
    {
        float a0 = 0.f, a1 = 0.f;
#pragma unroll
        for (int tt = 0; tt < 4; ++tt) { a0 += P.l0[tt]; a1 += P.l1[tt]; c0[tt] = a0; c1[tt] = a1; kkw[tt] = P.kk[tt]; qw[tt] = P.q[tt]; }
        *(LAS f32x2v*)(lds + HG_PT + (part * 128 + k0) * 4) = (f32x2v){a0, a1};
        const int s = tid >> 4, ch = tid & 15;
        *(LAS v4u*)(lds + HG_VS + s * HG_VSS + ch * 16) = P.v;
        asm volatile("" ::: "memory");
        og_cur = P.og;
        if (has_next) hg_prefetch<FULL>(F, P, row0_next, nvalid_next, h);
    }
    HG_BAR();
    {
        float base0 = 0.f, base1 = 0.f, tot0 = 0.f, tot1 = 0.f;
#pragma unroll
        for (int p = 0; p < 8; ++p) { const f32x2v pv = *(const LAS f32x2v*)(lds + HG_PT + (p * 128 + k0) * 4); if (p < part) { base0 += pv.x; base1 += pv.y; } tot0 += pv.x; tot1 += pv.y; }
        unsigned ke0[2], ke1[2];
        float e0[4], e1[4];
#pragma unroll
        for (int tt = 0; tt < 4; ++tt) {
            const int t = 4 * part + tt;
            const float b0 = base0 + c0[tt], b1 = base1 + c1[tt];
            const float kk0 = __uint_as_float(kkw[tt] << 16), kk1 = __uint_as_float(kkw[tt] & 0xffff0000u);
            if (FULL) {
                const float q0 = __uint_as_float(qw[tt] << 16), q1 = __uint_as_float(qw[tt] & 0xffff0000u);
                *(LAS unsigned*)(lds + HG_QD + t * HG_RS + k0 * 2) = cvtpk(q0 * __expf(b0), q1 * __expf(b1));
                *(LAS unsigned*)(lds + HG_KD + t * HG_RS + k0 * 2) = cvtpk(kk0 * __expf(-b0), kk1 * __expf(-b1));
            }
            e0[tt] = kk0 * __expf(tot0 - b0); e1[tt] = kk1 * __expf(tot1 - b1);
        }
        ke0[0] = cvtpk(e0[0], e0[1]); ke0[1] = cvtpk(e0[2], e0[3]); ke1[0] = cvtpk(e1[0], e1[1]); ke1[1] = cvtpk(e1[2], e1[3]);
        *(LAS u32x2v*)(lds + HG_KET + k0 * HG_KES + part * 8) = (u32x2v){ke0[0], ke0[1]};
        *(LAS u32x2v*)(lds + HG_KET + (k0 + 1) * HG_KES + part * 8) = (u32x2v){ke1[0], ke1[1]};
        if (part == 0) { *(LAS f32x2v*)(lds + HG_DV + k0 * 4) = (f32x2v){__expf(tot0), __expf(tot1)}; bs0 += tot0; bs1 += tot1; }
    }
    HG_BAR();
    const unsigned ldsb = (unsigned)(size_t)lds;
    const unsigned vcol = (unsigned)((16 * w + 4 * (l15 & 3)) * 2);
    const unsigned vbA = ldsb + HG_VS + (4 * kq + (l15 >> 2)) * HG_VSS + vcol;
    const unsigned vbB = ldsb + HG_VS + (8 * kq + (l15 >> 2)) * HG_VSS + vcol;
#define PK8(L, H) (bf16x8){L[0], L[1], L[2], L[3], H[0], H[1], H[2], H[3]}
    f32x4 o0 = {0.f, 0.f, 0.f, 0.f}, o1 = {0.f, 0.f, 0.f, 0.f};
    if (FULL) {
        f32x4 X00 = {0.f, 0.f, 0.f, 0.f}, X01 = X00, X11 = X00;
#pragma unroll
        for (int ks = 0; ks < 4; ++ks) {
            const bf16x8 ka0 = *(const LAS bf16x8*)(lds + HG_KD + l15 * HG_RS + (32 * ks + 8 * kq) * 2), ka1 = *(const LAS bf16x8*)(lds + HG_KD + (16 + l15) * HG_RS + (32 * ks + 8 * kq) * 2);
            const bf16x8 qb0 = *(const LAS bf16x8*)(lds + HG_QD + l15 * HG_RS + (32 * ks + 8 * kq) * 2), qb1 = *(const LAS bf16x8*)(lds + HG_QD + (16 + l15) * HG_RS + (32 * ks + 8 * kq) * 2);
            X00 = MFMA16(ka0, qb0, X00); X01 = MFMA16(ka0, qb1, X01); X11 = MFMA16(ka1, qb1, X11);
        }
#pragma unroll
        for (int r = 0; r < 4; ++r) { const bool keep = (4 * kq + r) <= l15; X00[r] = keep ? X00[r] : 0.f; X11[r] = keep ? X11[r] : 0.f; }
        v4u xa0, xa1;
        xa0.x = cvtpk(X00[0], X00[1]); xa0.y = cvtpk(X00[2], X00[3]); xa0.z = 0u; xa0.w = 0u;
        xa1.x = cvtpk(X01[0], X01[1]); xa1.y = cvtpk(X01[2], X01[3]); xa1.z = cvtpk(X11[0], X11[1]); xa1.w = cvtpk(X11[2], X11[3]);
#pragma unroll
        for (int ks = 0; ks < 4; ++ks) {
            v4u sb; sb.x = cvtpk(S[2 * ks][0], S[2 * ks][1]); sb.y = cvtpk(S[2 * ks][2], S[2 * ks][3]); sb.z = cvtpk(S[2 * ks + 1][0], S[2 * ks + 1][1]); sb.w = cvtpk(S[2 * ks + 1][2], S[2 * ks + 1][3]);
            const bf16x8 Bs = __builtin_bit_cast(bf16x8, sb);
            const s16x4 qa0l = *(const LAS s16x4*)(lds + HG_QD + l15 * HG_RS + (32 * ks + 4 * kq) * 2), qa0h = *(const LAS s16x4*)(lds + HG_QD + l15 * HG_RS + (32 * ks + 16 + 4 * kq) * 2);
            const s16x4 qa1l = *(const LAS s16x4*)(lds + HG_QD + (16 + l15) * HG_RS + (32 * ks + 4 * kq) * 2), qa1h = *(const LAS s16x4*)(lds + HG_QD + (16 + l15) * HG_RS + (32 * ks + 16 + 4 * kq) * 2);
            o0 = MFMA16(PK8(qa0l, qa0h), Bs, o0); o1 = MFMA16(PK8(qa1l, qa1h), Bs, o1);
        }
        const s16x4 vp0 = tr_read<0>(vbA), vp1 = tr_read<16 * HG_VSS>(vbA);
        asm volatile("s_waitcnt lgkmcnt(0)" ::: "memory"); __builtin_amdgcn_sched_barrier(0);
        const bf16x8 Vp = PK8(vp0, vp1);
        o0 = MFMA16(__builtin_bit_cast(bf16x8, xa0), Vp, o0); o1 = MFMA16(__builtin_bit_cast(bf16x8, xa1), Vp, o1);
    }
    {
        const s16x4 vn0 = tr_read<0>(vbB), vn1 = tr_read<4 * HG_VSS>(vbB);
        asm volatile("s_waitcnt lgkmcnt(0)" ::: "memory"); __builtin_amdgcn_sched_barrier(0);
        const bf16x8 Vn = PK8(vn0, vn1);
#pragma unroll
        for (int kt = 0; kt < 8; ++kt) {
            const f32x4 dk = *(const LAS f32x4*)(lds + HG_DV + (16 * kt + 4 * kq) * 4);
            const bf16x8 a = *(const LAS bf16x8*)(lds + HG_KET + (16 * kt + l15) * HG_KES + 16 * kq);
            S[kt] = MFMA16(a, Vn, S[kt] * dk);
        }
    }
#undef PK8
    if (FULL) {
#pragma unroll
        for (int r = 0; r < 4; ++r) {
            *(LAS float*)(lds + HG_OB + (4 * kq + r) * HG_OBS + (16 * w + l15) * 4) = o0[r];
            *(LAS float*)(lds + HG_OB + (16 + 4 * kq + r) * HG_OBS + (16 * w + l15) * 4) = o1[r];
        }
    }
    HG_BAR();
    if (FULL) {
        const int t = tid >> 4, c = tid & 15;
        const f32x4 a = *(const LAS f32x4*)(lds + HG_OB + t * HG_OBS + c * 32), b = *(const LAS f32x4*)(lds + HG_OB + t * HG_OBS + c * 32 + 16);
        float ss = (a[0] * a[0] + a[1] * a[1]) + (a[2] * a[2] + a[3] * a[3]) + (b[0] * b[0] + b[1] * b[1]) + (b[2] * b[2] + b[3] * b[3]);
        ss += __shfl_xor(ss, 1); ss += __shfl_xor(ss, 2); ss += __shfl_xor(ss, 4); ss += __shfl_xor(ss, 8);
        if (t < nvalid) {
            const float rstd = rsqrtf(ss * (1.0f / 128.0f) + 1e-6f);
            const size_t off = (row0 + t) * 2048 + h * 128 + c * 8;
            f32x4 ga, gb; pg8::EpiEw<0>::unpk(og_cur, ga, gb);
            pg8::st_bf16x8(OHG + off, a * rstd * w0 * ga, b * rstd * w1 * gb);
        }
    }
}

__device__ __forceinline__ void hgrn_pass_a(Frame& F, const Args& A) {
    float* SST = (float*)(F.ws + WS_SST); float* DSC = (float*)(F.ws + WS_DSC);
    const int lane = F.lane, w = F.wave, l15 = lane & 15, kq = lane >> 4;
    for (int unit = blockIdx.x; unit < 512; unit += F.G) {
        const int h = unit >> 5, sc = unit & 31;
        f32x4 S[8];
#pragma unroll
        for (int kt = 0; kt < 8; ++kt) S[kt] = (f32x4){0.f, 0.f, 0.f, 0.f};
        float bs0 = 0.f, bs1 = 0.f;
        HgPre P; hg_prefetch<false>(F, P, (size_t)sc * 256, 32, h);
        for (int c = 0; c < 8; ++c) hgrn_chunk<false>(F, S, bs0, bs1, P, (size_t)sc * 256 + c * 32, 32, h, nullptr, c + 1 < 8, (size_t)sc * 256 + (c + 1) * 32, 32);
        float* dst = SST + (size_t)(h * 32 + sc) * 16384;
#pragma unroll
        for (int kt = 0; kt < 8; ++kt)
#pragma unroll
            for (int r = 0; r < 4; ++r) dst[(16 * kt + 4 * kq + r) * 128 + 16 * w + l15] = S[kt][r];
        if (w == 0) *(f32x2v*)(DSC + (size_t)(h * 32 + sc) * 128 + 2 * lane) = (f32x2v){__expf(bs0), __expf(bs1)};
    }
}
__device__ __forceinline__ void hgrn_scan(Frame& F, const Args& A) {
    float* SST = (float*)(F.ws + WS_SST); const float* DSC = (const float*)(F.ws + WS_DSC);
    for (int idx = blockIdx.x * (NWAVES * 64) + F.tid; idx < 16 * 16384; idx += F.G * NWAVES * 64) {
        const int h = idx >> 14, e = idx & 16383, k = e >> 7;
        float s = 0.f, lv[32], dv[32];
#pragma unroll
        for (int sc = 0; sc < 32; ++sc) { lv[sc] = SST[(size_t)(h * 32 + sc) * 16384 + e]; dv[sc] = DSC[(h * 32 + sc) * 128 + k]; }
#pragma unroll
        for (int sc = 0; sc < 32; ++sc) { SST[(size_t)(h * 32 + sc) * 16384 + e] = s; s = dv[sc] * s + lv[sc]; }
        F.out[pg8::O_STP + (size_t)h * 16384 + e] = s;
    }
}
__device__ __forceinline__ void hgrn_pass_c(Frame& F, const Args& A) {
    const float* SST = (const float*)(F.ws + WS_SST);
    const int lane = F.lane, w = F.wave, l15 = lane & 15, kq = lane >> 4;
    const float* ghg = A.in[I_GHG];
    const f32x4 gw0 = *(const f32x4*)(ghg + (F.tid & 15) * 8), gw1 = *(const f32x4*)(ghg + (F.tid & 15) * 8 + 4);
    for (int unit = blockIdx.x; unit < 1024; unit += F.G) {
        int h, nch, nvalid; size_t row0; const float* sin; float* sout = nullptr;
        if (unit < 512) { h = unit >> 5; const int sc = unit & 31; row0 = (size_t)sc * 256; nch = 8; nvalid = 32; sin = SST + (size_t)(h * 32 + sc) * 16384; }
        else { const int u2 = unit - 512, b = u2 >> 4; h = u2 & 15; row0 = (size_t)TOKP + b * 8; nch = 1; nvalid = 8; sin = A.in[I_ST] + (size_t)(b * 16 + h) * 16384; sout = F.out + pg8::O_STS + (size_t)(b * 16 + h) * 16384; }
        f32x4 S[8];
#pragma unroll
        for (int kt = 0; kt < 8; ++kt)
#pragma unroll
            for (int r = 0; r < 4; ++r) S[kt][r] = sin[(16 * kt + 4 * kq + r) * 128 + 16 * w + l15];
        float bs0 = 0.f, bs1 = 0.f;
        HgPre P; hg_prefetch<true>(F, P, row0, nvalid, h);
        for (int c = 0; c < nch; ++c) hgrn_chunk<true>(F, S, bs0, bs1, P, row0 + (size_t)c * 32, nvalid, h, ghg, c + 1 < nch, row0 + (size_t)(c + 1) * 32, nvalid, gw0, gw1);
        if (sout) {
#pragma unroll
            for (int kt = 0; kt < 8; ++kt)
#pragma unroll
                for (int r = 0; r < 4; ++r) sout[(16 * kt + 4 * kq + r) * 128 + 16 * w + l15] = S[kt][r];
        }
    }
}

constexpr int HG_SET = HG_END;
static_assert(2 * HG_SET <= TAB_OFF, "hgrn LDS map (two sets)");
template <bool FULL>
__device__ __forceinline__ void hgrn_chunk2(Frame& F, f32x4 (&S)[2][8], float (&bs0)[2], float (&bs1)[2], HgPre (&P)[2], const size_t (&row0)[2], const int nvalid, const int (&h)[2],
                                            const bool has_next, const size_t (&row0n)[2], const int nvalid_next, const f32x4 w0 = (f32x4){0.f, 0.f, 0.f, 0.f}, const f32x4 w1 = (f32x4){0.f, 0.f, 0.f, 0.f}) {
    bf16* OHG = (bf16*)(F.ws + WS_OHG);
    const int tid = F.tid, lane = F.lane, w = F.wave, l15 = lane & 15, kq = lane >> 4;
    LAS unsigned char* lds0 = F.lds;
    const int kp = lane, part = w, k0 = 2 * kp;
    float c0[2][4], c1[2][4]; unsigned kkw[2][4], qw[2][4]; v4u og_cur[2];
#pragma unroll
    for (int u = 0; u < 2; ++u) {
        LAS unsigned char* lds = lds0 + u * HG_SET;
        float a0 = 0.f, a1 = 0.f;
#pragma unroll
        for (int tt = 0; tt < 4; ++tt) { a0 += P[u].l0[tt]; a1 += P[u].l1[tt]; c0[u][tt] = a0; c1[u][tt] = a1; kkw[u][tt] = P[u].kk[tt]; qw[u][tt] = P[u].q[tt]; }
        *(LAS f32x2v*)(lds + HG_PT + (part * 128 + k0) * 4) = (f32x2v){a0, a1};
        const int s = tid >> 4, ch = tid & 15;
        *(LAS v4u*)(lds + HG_VS + s * HG_VSS + ch * 16) = P[u].v;
        og_cur[u] = P[u].og;
    }
    asm volatile("" ::: "memory");
    if (has_next) {
#pragma unroll
        for (int u = 0; u < 2; ++u) hg_prefetch<FULL>(F, P[u], row0n[u], nvalid_next, h[u]);
    }
    HG_BAR();
#pragma unroll
    for (int u = 0; u < 2; ++u) {
        LAS unsigned char* lds = lds0 + u * HG_SET;
        float base0 = 0.f, base1 = 0.f, tot0 = 0.f, tot1 = 0.f;
#pragma unroll
        for (int p = 0; p < 8; ++p) { const f32x2v pv = *(const LAS f32x2v*)(lds + HG_PT + (p * 128 + k0) * 4); if (p < part) { base0 += pv.x; base1 += pv.y; } tot0 += pv.x; tot1 += pv.y; }
        unsigned ke0[2], ke1[2];
        float e0[4], e1[4];
#pragma unroll
        for (int tt = 0; tt < 4; ++tt) {
            const int t = 4 * part + tt;
            const float b0 = base0 + c0[u][tt], b1 = base1 + c1[u][tt];
            const float kk0 = __uint_as_float(kkw[u][tt] << 16), kk1 = __uint_as_float(kkw[u][tt] & 0xffff0000u);
            if (FULL) {
                const float q0 = __uint_as_float(qw[u][tt] << 16), q1 = __uint_as_float(qw[u][tt] & 0xffff0000u);
                *(LAS unsigned*)(lds + HG_QD + t * HG_RS + k0 * 2) = cvtpk(q0 * __expf(b0), q1 * __expf(b1));
                *(LAS unsigned*)(lds + HG_KD + t * HG_RS + k0 * 2) = cvtpk(kk0 * __expf(-b0), kk1 * __expf(-b1));
            }
            e0[tt] = kk0 * __expf(tot0 - b0); e1[tt] = kk1 * __expf(tot1 - b1);
        }
        ke0[0] = cvtpk(e0[0], e0[1]); ke0[1] = cvtpk(e0[2], e0[3]); ke1[0] = cvtpk(e1[0], e1[1]); ke1[1] = cvtpk(e1[2], e1[3]);
        *(LAS u32x2v*)(lds + HG_KET + k0 * HG_KES + part * 8) = (u32x2v){ke0[0], ke0[1]};
        *(LAS u32x2v*)(lds + HG_KET + (k0 + 1) * HG_KES + part * 8) = (u32x2v){ke1[0], ke1[1]};
        if (part == 0) { *(LAS f32x2v*)(lds + HG_DV + k0 * 4) = (f32x2v){__expf(tot0), __expf(tot1)}; bs0[u] += tot0; bs1[u] += tot1; }
    }
    HG_BAR();
    const unsigned ldsb = (unsigned)(size_t)lds0;
    const unsigned vcol = (unsigned)((16 * w + 4 * (l15 & 3)) * 2);
    const unsigned vbA = ldsb + HG_VS + (4 * kq + (l15 >> 2)) * HG_VSS + vcol;
    const unsigned vbB = ldsb + HG_VS + (8 * kq + (l15 >> 2)) * HG_VSS + vcol;
#define PK8(L, H) (bf16x8){L[0], L[1], L[2], L[3], H[0], H[1], H[2], H[3]}
    f32x4 o0[2], o1[2];
#pragma unroll
    for (int u = 0; u < 2; ++u) { o0[u] = (f32x4){0.f, 0.f, 0.f, 0.f}; o1[u] = o0[u]; }
    if (FULL) {
        f32x4 X00[2], X01[2], X11[2];
#pragma unroll
        for (int u = 0; u < 2; ++u) { X00[u] = (f32x4){0.f, 0.f, 0.f, 0.f}; X01[u] = X00[u]; X11[u] = X00[u]; }
#pragma unroll
        for (int ks = 0; ks < 4; ++ks)
#pragma unroll
            for (int u = 0; u < 2; ++u) {
                LAS unsigned char* lds = lds0 + u * HG_SET;
                const bf16x8 ka0 = *(const LAS bf16x8*)(lds + HG_KD + l15 * HG_RS + (32 * ks + 8 * kq) * 2), ka1 = *(const LAS bf16x8*)(lds + HG_KD + (16 + l15) * HG_RS + (32 * ks + 8 * kq) * 2);
                const bf16x8 qb0 = *(const LAS bf16x8*)(lds + HG_QD + l15 * HG_RS + (32 * ks + 8 * kq) * 2), qb1 = *(const LAS bf16x8*)(lds + HG_QD + (16 + l15) * HG_RS + (32 * ks + 8 * kq) * 2);
                X00[u] = MFMA16(ka0, qb0, X00[u]); X01[u] = MFMA16(ka0, qb1, X01[u]); X11[u] = MFMA16(ka1, qb1, X11[u]);
            }
        v4u xa0[2], xa1[2];
#pragma unroll
        for (int u = 0; u < 2; ++u) {
#pragma unroll
            for (int r = 0; r < 4; ++r) { const bool keep = (4 * kq + r) <= l15; X00[u][r] = keep ? X00[u][r] : 0.f; X11[u][r] = keep ? X11[u][r] : 0.f; }
            xa0[u].x = cvtpk(X00[u][0], X00[u][1]); xa0[u].y = cvtpk(X00[u][2], X00[u][3]); xa0[u].z = 0u; xa0[u].w = 0u;
            xa1[u].x = cvtpk(X01[u][0], X01[u][1]); xa1[u].y = cvtpk(X01[u][2], X01[u][3]); xa1[u].z = cvtpk(X11[u][0], X11[u][1]); xa1[u].w = cvtpk(X11[u][2], X11[u][3]);
        }
#pragma unroll
        for (int ks = 0; ks < 4; ++ks)
#pragma unroll
            for (int u = 0; u < 2; ++u) {
                LAS unsigned char* lds = lds0 + u * HG_SET;
                v4u sb; sb.x = cvtpk(S[u][2 * ks][0], S[u][2 * ks][1]); sb.y = cvtpk(S[u][2 * ks][2], S[u][2 * ks][3]); sb.z = cvtpk(S[u][2 * ks + 1][0], S[u][2 * ks + 1][1]); sb.w = cvtpk(S[u][2 * ks + 1][2], S[u][2 * ks + 1][3]);
                const bf16x8 Bs = __builtin_bit_cast(bf16x8, sb);
                const s16x4 qa0l = *(const LAS s16x4*)(lds + HG_QD + l15 * HG_RS + (32 * ks + 4 * kq) * 2), qa0h = *(const LAS s16x4*)(lds + HG_QD + l15 * HG_RS + (32 * ks + 16 + 4 * kq) * 2);
                const s16x4 qa1l = *(const LAS s16x4*)(lds + HG_QD + (16 + l15) * HG_RS + (32 * ks + 4 * kq) * 2), qa1h = *(const LAS s16x4*)(lds + HG_QD + (16 + l15) * HG_RS + (32 * ks + 16 + 4 * kq) * 2);
                o0[u] = MFMA16(PK8(qa0l, qa0h), Bs, o0[u]); o1[u] = MFMA16(PK8(qa1l, qa1h), Bs, o1[u]);
            }
        const s16x4 vp00 = tr_read<0>(vbA), vp01 = tr_read<16 * HG_VSS>(vbA), vp10 = tr_read<0>(vbA + HG_SET), vp11 = tr_read<16 * HG_VSS>(vbA + HG_SET);
        asm volatile("s_waitcnt lgkmcnt(0)" ::: "memory"); __builtin_amdgcn_sched_barrier(0);
        const bf16x8 Vp0 = PK8(vp00, vp01), Vp1 = PK8(vp10, vp11);
        o0[0] = MFMA16(__builtin_bit_cast(bf16x8, xa0[0]), Vp0, o0[0]); o1[0] = MFMA16(__builtin_bit_cast(bf16x8, xa1[0]), Vp0, o1[0]);
        o0[1] = MFMA16(__builtin_bit_cast(bf16x8, xa0[1]), Vp1, o0[1]); o1[1] = MFMA16(__builtin_bit_cast(bf16x8, xa1[1]), Vp1, o1[1]);
    }
    {
        const s16x4 vn00 = tr_read<0>(vbB), vn01 = tr_read<4 * HG_VSS>(vbB), vn10 = tr_read<0>(vbB + HG_SET), vn11 = tr_read<4 * HG_VSS>(vbB + HG_SET);
        asm volatile("s_waitcnt lgkmcnt(0)" ::: "memory"); __builtin_amdgcn_sched_barrier(0);
        const bf16x8 Vn0 = PK8(vn00, vn01), Vn1 = PK8(vn10, vn11);
#pragma unroll
        for (int kt = 0; kt < 8; ++kt)
#pragma unroll
            for (int u = 0; u < 2; ++u) {
                LAS unsigned char* lds = lds0 + u * HG_SET;
                const f32x4 dk = *(const LAS f32x4*)(lds + HG_DV + (16 * kt + 4 * kq) * 4);
                const bf16x8 a = *(const LAS bf16x8*)(lds + HG_KET + (16 * kt + l15) * HG_KES + 16 * kq);
                S[u][kt] = MFMA16(a, u ? Vn1 : Vn0, S[u][kt] * dk);
            }
    }
#undef PK8
    if (FULL) {
#pragma unroll
        for (int u = 0; u < 2; ++u)
#pragma unroll
            for (int r = 0; r < 4; ++r) {
                *(LAS float*)(lds0 + u * HG_SET + HG_OB + (4 * kq + r) * HG_OBS + (16 * w + l15) * 4) = o0[u][r];
                *(LAS float*)(lds0 + u * HG_SET + HG_OB + (16 + 4 * kq + r) * HG_OBS + (16 * w + l15) * 4) = o1[u][r];
            }
    }
    HG_BAR();
    if (FULL) {
        const int t = tid >> 4, c = tid & 15;
        f32x4 a[2], b[2]; float ss[2];
#pragma unroll
        for (int u = 0; u < 2; ++u) {
            a[u] = *(const LAS f32x4*)(lds0 + u * HG_SET + HG_OB + t * HG_OBS + c * 32); b[u] = *(const LAS f32x4*)(lds0 + u * HG_SET + HG_OB + t * HG_OBS + c * 32 + 16);
            ss[u] = (a[u][0] * a[u][0] + a[u][1] * a[u][1]) + (a[u][2] * a[u][2] + a[u][3] * a[u][3]) + (b[u][0] * b[u][0] + b[u][1] * b[u][1]) + (b[u][2] * b[u][2] + b[u][3] * b[u][3]);
        }
#pragma unroll
        for (int st = 1; st < 16; st <<= 1) { const float x0 = __shfl_xor(ss[0], st), x1 = __shfl_xor(ss[1], st); ss[0] += x0; ss[1] += x1; }
        if (t < nvalid) {
#pragma unroll
            for (int u = 0; u < 2; ++u) {
                const float rstd = rsqrtf(ss[u] * (1.0f / 128.0f) + 1e-6f);
                const size_t off = (row0[u] + t) * 2048 + h[u] * 128 + c * 8;
                f32x4 ga, gb; pg8::EpiEw<0>::unpk(og_cur[u], ga, gb);
                pg8::st_bf16x8(OHG + off, a[u] * rstd * w0 * ga, b[u] * rstd * w1 * gb);
            }
        }
    }
}
__device__ __forceinline__ void hgrn_pass_a2(Frame& F, const Args& A) {
    float* SST = (float*)(F.ws + WS_SST); float* DSC = (float*)(F.ws + WS_DSC);
    const int lane = F.lane, w = F.wave, l15 = lane & 15, kq = lane >> 4;
    const int un[2] = {(int)blockIdx.x, (int)blockIdx.x + 256};
    const int h[2] = {un[0] >> 5, un[1] >> 5}, sc = un[0] & 31;
    f32x4 S[2][8];
#pragma unroll
    for (int u = 0; u < 2; ++u)
#pragma unroll
        for (int kt = 0; kt < 8; ++kt) S[u][kt] = (f32x4){0.f, 0.f, 0.f, 0.f};
    float bs0[2] = {0.f, 0.f}, bs1[2] = {0.f, 0.f};
    HgPre P[2];
#pragma unroll
    for (int u = 0; u < 2; ++u) hg_prefetch<false>(F, P[u], (size_t)sc * 256, 32, h[u]);
    for (int c = 0; c < 8; ++c) {
        const size_t r0[2] = {(size_t)sc * 256 + c * 32, (size_t)sc * 256 + c * 32}, rn[2] = {r0[0] + 32, r0[1] + 32};
        hgrn_chunk2<false>(F, S, bs0, bs1, P, r0, 32, h, c + 1 < 8, rn, 32);
    }
#pragma unroll
    for (int u = 0; u < 2; ++u) {
        float* dst = SST + (size_t)(h[u] * 32 + sc) * 16384;
#pragma unroll
        for (int kt = 0; kt < 8; ++kt)
#pragma unroll
            for (int r = 0; r < 4; ++r) dst[(16 * kt + 4 * kq + r) * 128 + 16 * w + l15] = S[u][kt][r];
        if (w == 0) *(f32x2v*)(DSC + (size_t)(h[u] * 32 + sc) * 128 + 2 * lane) = (f32x2v){__expf(bs0[u]), __expf(bs1[u])};
    }
}
__device__ __forceinline__ void hgrn_pass_c2(Frame& F, const Args& A) {
    const float* SST = (const float*)(F.ws + WS_SST);
    const int lane = F.lane, w = F.wave, l15 = lane & 15, kq = lane >> 4;
    const float* ghg = A.in[I_GHG];
    const f32x4 gw0 = *(const f32x4*)(ghg + (F.tid & 15) * 8), gw1 = *(const f32x4*)(ghg + (F.tid & 15) * 8 + 4);
    for (int kind = 0; kind < 2; ++kind) {
        int h[2], nch, nvalid; size_t row0[2]; const float* sin[2]; float* sout[2] = {nullptr, nullptr};
#pragma unroll
        for (int u = 0; u < 2; ++u) {
            const int u2 = (int)blockIdx.x + 256 * u;
            if (kind == 0) { h[u] = u2 >> 5; const int sc = u2 & 31; row0[u] = (size_t)sc * 256; sin[u] = SST + (size_t)(h[u] * 32 + sc) * 16384; }
            else { const int b = u2 >> 4; h[u] = u2 & 15; row0[u] = (size_t)TOKP + b * 8; sin[u] = A.in[I_ST] + (size_t)(b * 16 + h[u]) * 16384; sout[u] = F.out + pg8::O_STS + (size_t)(b * 16 + h[u]) * 16384; }
        }
        nch = kind == 0 ? 8 : 1; nvalid = kind == 0 ? 32 : 8;
        f32x4 S[2][8];
        int lo = ((4 * kq) * 128 + 16 * w + l15) * 4; asm volatile("" : "+v"(lo));
#pragma unroll
        for (int u = 0; u < 2; ++u) {
            const GAS char* sb = (const GAS char*)sin[u];
#pragma unroll
            for (int kt = 0; kt < 8; ++kt)
#pragma unroll
                for (int r = 0; r < 4; ++r) S[u][kt][r] = *(const GAS float*)(sb + (unsigned)(lo + (16 * kt + r) * 512));
        }
        float bs0[2] = {0.f, 0.f}, bs1[2] = {0.f, 0.f};
        HgPre P[2];
#pragma unroll
        for (int u = 0; u < 2; ++u) hg_prefetch<true>(F, P[u], row0[u], nvalid, h[u]);
        for (int c = 0; c < nch; ++c) {
            const size_t r0[2] = {row0[0] + (size_t)c * 32, row0[1] + (size_t)c * 32}, rn[2] = {r0[0] + 32, r0[1] + 32};
            hgrn_chunk2<true>(F, S, bs0, bs1, P, r0, nvalid, h, c + 1 < nch, rn, nvalid, gw0, gw1);
        }
        if (kind == 1) {
            asm volatile("" : "+v"(lo));
#pragma unroll
            for (int u = 0; u < 2; ++u) {
                GAS char* sb = (GAS char*)sout[u];
#pragma unroll
                for (int kt = 0; kt < 8; ++kt)
#pragma unroll
                    for (int r = 0; r < 4; ++r) *(GAS float*)(sb + (unsigned)(lo + (16 * kt + r) * 512)) = S[u][kt][r];
            }
        }
    }
}

__device__ __forceinline__ void hgrn_naive_phase(Frame& F, const Args& A) {
    const bf16* HQ = (const bf16*)(F.ws + WS_HQ); const bf16* KK = (const bf16*)(F.ws + WS_KK); const bf16* HI = (const bf16*)(F.ws + WS_HI); const bf16* OG = (const bf16*)(F.ws + WS_OG);
    const float* LG = (const float*)(F.ws + WS_LG); bf16* OHG = (bf16*)(F.ws + WS_OHG);
    const float* ghg = A.in[I_GHG];
    LAS float* qs = (LAS float*)(F.lds);
    LAS float* ks = qs + 1024; LAS float* gs = ks + 1024; LAS float* vs = gs + 1024;
    LAS float* part = vs + 1024;
    const int tid = F.tid, v = tid & 127, kq = tid >> 7;
    for (int unit = blockIdx.x; unit < 16 + 512; unit += F.G) {
        int h, row_base, T; float* sout; const float* s0 = nullptr;
        if (unit < 16) { h = unit; row_base = 0; T = TOKP; sout = F.out + pg8::O_STP + (size_t)h * 16384; }
        else { const int b = (unit - 16) >> 4; h = (unit - 16) & 15; row_base = TOKP + b * 8; T = 8; sout = F.out + pg8::O_STS + (size_t)(b * 16 + h) * 16384; s0 = A.in[I_ST] + (size_t)(b * 16 + h) * 16384; }
        float S[32];
#pragma unroll
        for (int i = 0; i < 32; ++i) S[i] = s0 ? s0[(size_t)(32 * kq + i) * 128 + v] : 0.f;
        for (int t0 = 0; t0 < T; t0 += 8) {
            __syncthreads();
#pragma unroll
            for (int e = 0; e < 2; ++e) { const int idx = tid + 512 * e, tt = idx >> 7, k = idx & 127; const size_t off = (size_t)(row_base + t0 + tt) * 2048 + h * 128 + k;
                qs[idx] = bf2f(HQ[off]); ks[idx] = bf2f(KK[off]); gs[idx] = __expf(LG[off]); vs[idx] = bf2f(HI[off]); }
            __syncthreads();
#pragma unroll 1
            for (int tt = 0; tt < 8; ++tt) {
                const float vv = vs[tt * 128 + v]; float po = 0.f;
#pragma unroll
                for (int i = 0; i < 32; ++i) { const int k = 32 * kq + i; S[i] = gs[tt * 128 + k] * S[i] + ks[tt * 128 + k] * vv; po += S[i] * qs[tt * 128 + k]; }
                part[(tt * 4 + kq) * 128 + v] = po;
            }
            __syncthreads();
            {
                const int tt = F.wave, l = F.lane; const size_t ro = (size_t)(row_base + t0 + tt) * 2048 + h * 128;
                const float a0 = part[(tt * 4 + 0) * 128 + 2 * l] + part[(tt * 4 + 1) * 128 + 2 * l] + part[(tt * 4 + 2) * 128 + 2 * l] + part[(tt * 4 + 3) * 128 + 2 * l];
                const float a1 = part[(tt * 4 + 0) * 128 + 2 * l + 1] + part[(tt * 4 + 1) * 128 + 2 * l + 1] + part[(tt * 4 + 2) * 128 + 2 * l + 1] + part[(tt * 4 + 3) * 128 + 2 * l + 1];
                const float rstd = rsqrtf(wave_sum(a0 * a0 + a1 * a1) * (1.0f / 128.0f) + 1e-6f);
                const unsigned ogw = *(const unsigned*)(OG + ro + 2 * l);
                *(unsigned*)(OHG + ro + 2 * l) = pk2(a0 * rstd * ghg[2 * l] * __uint_as_float(ogw << 16), a1 * rstd * ghg[2 * l + 1] * __uint_as_float(ogw & 0xffff0000u));
            }
        }
#pragma unroll
        for (int i = 0; i < 32; ++i) sout[(size_t)(32 * kq + i) * 128 + v] = S[i];
        __syncthreads();
    }
}

#ifndef WGM_A
#define WGM_A 4
#endif
#ifndef WGM_B
#define WGM_B 4
#endif
#ifndef WGM_9
#define WGM_9 4
#endif
#ifndef WGM_11
#define WGM_11 4
#endif
__global__ void __launch_bounds__(NWAVES * 64, 2) fwd_kernel(Args args) {
    extern __shared__ __attribute__((aligned(16))) unsigned char lds[];
    Frame F;
    F.lds = (LAS unsigned char*)lds;
    volatile LAS unsigned* MISC = (volatile LAS unsigned*)(F.lds + MISC_OFF);
    F.tid = threadIdx.x; F.lane = F.tid & 63; F.wave = __builtin_amdgcn_readfirstlane(F.tid >> 6); F.G = gridDim.x;
    F.out = args.out; F.ws = args.ws;
    unsigned char* ws = args.ws;
    gu32* ctl = (gu32*)(ws + WS_CTL);
    for (int u = F.tid; u < 32; u += NWAVES * 64) MISC[u] = 0u;
    __syncthreads();
    XcdBarrier bar = xcd_barrier_post((unsigned*)(ctl + CW_BAR), MISC + 8);
    const int lo = args.ph_lo, hi = args.ph_hi;
#ifndef PROBE_MASK
#define PROBE_MASK 0
#endif
#ifndef PROBE_REP
#define PROBE_REP 3
#endif
    unsigned long long pr_prev = PROBE_MASK ? rt() : 0ull, pr_acc = 0ull;
    unsigned clk_mhz = 0u;
#define PROBE_MARK(k) do { if (PROBE_MASK) { const unsigned long long _n = rt(); if (PROBE_MASK & (1 << (k))) pr_acc += _n - pr_prev; pr_prev = _n; } } while (0)
#define IN(k) (lo <= (k) && (k) < hi)
#define BOTH(k) (IN(k) && IN((k) + 1))
#define GRID_BAR() xcd_barrier(bar)
    float* ssq = (float*)(ctl + CW_SSQ);
    typedef pg8::bf16_t pb;

    if (IN(0)) { p0_prologue(F, args); if (BOTH(0)) GRID_BAR(); PROBE_MARK(0); }

    if (IN(1)) {
        {
            pg8::Gemm g{(const pb*)(ws + WS_XB), (const pb*)(ws + WS_WIN), DM}; pg8::StaticOrder S; S.init(MTOK, IN16_N, DM, F.G, (int)blockIdx.x, WGM_A);
            pg8::EpiIn E{(pb*)(ws + WS_Q), (pb*)(ws + WS_K), (pb*)(ws + WS_V), (pb*)(ws + WS_HQ), (pb*)(ws + WS_KK), (pb*)(ws + WS_HI), (pb*)(ws + WS_OG), (pb*)(ws + WS_SA), (pb*)(ws + WS_SB),
                         (float*)(ws + WS_LG), (const float*)(ws + WS_R0), args.in[I_GQ], args.in[I_GK], args.in[I_LB], F.out, (PG8_LAS float*)(F.lds + TAB_OFF), IN16_LO / 256, 1.0f, 0};
            pg8::gemm_phase<pg8::EpiIn, pg8::StaticOrder, true, true>(F.lds + RING_OFF, g, S, E);
            {
                const int nb16 = (MTOK / 256) * (IN16_N / 256), rem16 = nb16 % F.G;
                const int nf8 = (MTOK / 256) * ((IN8_Q + IN8_G) / 256), n4 = nf8 / F.G, extra = nf8 - n4 * F.G;
                pg8::Gemm g8{(const pb*)(ws + WS_XF8), (const pb*)(ws + WS_WIN8), DM / 2}; pg8::TailOrder S8; S8.init(MTOK, IN8_Q + IN8_G, DM / 2, F.G, (int)blockIdx.x, n4, rem16, rem16 + extra, WGM_B);
                pg8::EpiIn E8 = E; E8.pn_split = IN8_Q / 256; E8.pn_off = 60 - IN8_Q / 256; E8.ascale = 0.015625f;
                pg8::gemm_phase<pg8::EpiIn, pg8::TailOrder, true, true, true>(F.lds + RING_OFF, g8, S8, E8);
            }
            if (F.G == 256 && (int)blockIdx.x >= P0_SL_LO) {
                const int c = (int)blockIdx.x, n = c < P0_SL_HI ? P0_DEF1 : P0_DEF1B,
                          base = P0_NITEMS - P0_NDEF + (c < P0_SL_HI ? (c - P0_SL_LO) * P0_DEF1 : (P0_SL_HI - P0_SL_LO) * P0_DEF1 + (c - P0_SL_HI) * P0_DEF1B);
                p0_items(F, args, base, base + n, F.wave, NWAVES);
                __syncthreads();
            }
#if defined(EXP_KLOOP) && EXP_KLOOP == 1
            { pg8::EpiNull EN; pg8::gemm_phase<pg8::EpiNull, pg8::StaticOrder, true, true>(F.lds + RING_OFF, g, S, EN); }
#endif
        }
        {
            pg8::Gemm g{(const pb*)(ws + WS_PB), (const pb*)(ws + WS_WPLE), PLED}; pg8::StaticOrder S; S.init(MTOK, DM, PLED, F.G, (int)blockIdx.x);
            pg8::EpiEw<0> E{(pb*)(ws + WS_PP), nullptr, nullptr, nullptr, nullptr, nullptr, nullptr, DM, nullptr, nullptr, 1};
            pg8::gemm_phase<pg8::EpiEw<0>, pg8::StaticOrder, true, true>(F.lds + RING_OFF, g, S, E);
        }
        if (BOTH(1)) GRID_BAR(); PROBE_MARK(1);
    }

    if (IN(2)) {
        const int spos = (int)(blockIdx.x % 3u);
        if (spos == 0) { attn_sample_phase(F, args); __syncthreads(); }
#if defined(EXP_KLOOP) && EXP_KLOOP == 5
        attn_sample_phase(F, args); __syncthreads();
#endif
#if defined(EXP_KLOOP) && EXP_KLOOP == 6
        attn_prompt_phase(F, args); __syncthreads();
#endif
#ifdef HG_SINGLE
        hgrn_pass_a(F, args);
#else
        if (F.G == 256) hgrn_pass_a2(F, args); else hgrn_pass_a(F, args);
#endif
        __syncthreads();
        if (spos == 1) { attn_sample_phase(F, args); __syncthreads(); }
        attn_prompt_phase(F, args);
        __syncthreads();
        if (spos == 2) attn_sample_phase(F, args);
        if (BOTH(2)) GRID_BAR(); PROBE_MARK(2);
    }
    if (IN(3)) {
        hgrn_scan(F, args);
        attn_merge_phase(F, args);
        if (BOTH(3)) GRID_BAR(); PROBE_MARK(3);
    }
    if (IN(4)) {
#ifdef HG_SINGLE
        hgrn_pass_c(F, args);
#else
        if (F.G == 256) hgrn_pass_c2(F, args); else hgrn_pass_c(F, args);
#endif
#if defined(EXP_KLOOP) && EXP_KLOOP == 2
        __syncthreads();
        hgrn_pass_c(F, args);
#endif
        if (BOTH(4)) GRID_BAR(); PROBE_MARK(4);
    }

    float* part = (float*)(ws + WS_PART);
    const int gtid = (int)blockIdx.x * (NWAVES * 64) + F.tid, gthreads = F.G * NWAVES * 64;
    if (IN(5)) {
        {
            pg8::Gemm g{(const pb*)(ws + WS_OATT), (const pb*)(ws + WS_WUPA), AW}; pg8::PanelOrder S; S.init(TOKP, DM, AW, F.G, (int)blockIdx.x, 4);
            pg8::EpiEw<1> E{(pb*)(ws + WS_P1B), (const pb*)(ws + WS_SA), nullptr, nullptr, nullptr, nullptr, nullptr, DM, nullptr, part, AW / 4};
            pg8::gemm_phase<pg8::EpiEw<1>, pg8::PanelOrder, true, true>(F.lds + RING_OFF, g, S, E);
        }
        if (F.G == 256 && (int)blockIdx.x >= 64) { const int base = P0_NITEMS - P0_NDEF2 + ((int)blockIdx.x - 64) * P0_DEF2; p0_items(F, args, base, base + P0_DEF2, F.wave, NWAVES); }
        VM_WAIT(); __syncthreads();
        {
            pg8::Gemm g{(const pb*)(ws + WS_OHG), (const pb*)(ws + WS_WUPH), HGW}; pg8::PanelOrder S; S.init(TOKP, DM, HGW, F.G, (int)blockIdx.x, 8);
            pg8::EpiEw<2> E{(pb*)(ws + WS_MRG), (const pb*)(ws + WS_SB), (const pb*)(ws + WS_P1B), nullptr, nullptr, nullptr, nullptr, DM, nullptr, part + (size_t)4 * 256 * DM, HGW / 8};
            pg8::gemm_phase<pg8::EpiEw<2>, pg8::PanelOrder, true, true>(F.lds + RING_OFF, g, S, E);
        }
        if (F.G == 256 && (int)blockIdx.x >= 128) { const int base = P0_NITEMS - P0_NDEF2 + (192 + (int)blockIdx.x - 128) * P0_DEF2; p0_items(F, args, base, base + P0_DEF2, F.wave, NWAVES); __syncthreads(); }
        if (BOTH(5)) GRID_BAR(); PROBE_MARK(5);
    }
    if (IN(6)) {
        for (int it = gtid; it < 256 * (DM / 8); it += gthreads) {
            const int rs_ = it >> 9, c8 = it & 511;
            f32x4 a1 = {0.f, 0.f, 0.f, 0.f}, b1 = a1, a2 = a1, b2 = a1;
            for (int sp = 0; sp < 4; ++sp) { const float* p = part + ((size_t)sp * 256 + rs_) * DM + c8 * 8; a1 += *(const f32x4*)p; b1 += *(const f32x4*)(p + 4); }
            for (int sp = 4; sp < 12; ++sp) { const float* p = part + ((size_t)sp * 256 + rs_) * DM + c8 * 8; a2 += *(const f32x4*)p; b2 += *(const f32x4*)(p + 4); }
            const size_t off = (size_t)(TOKP + rs_) * DM + c8 * 8;
            f32x4 sa0, sa1, sb0, sb1; pg8::ld_bf16x8((const pb*)(ws + WS_SA) + off, sa0, sa1); pg8::ld_bf16x8((const pb*)(ws + WS_SB) + off, sb0, sb1);
            pg8::st_bf16x8((pb*)(ws + WS_MRG) + off, a1 * sa0 + a2 * sb0, b1 * sa1 + b2 * sb1);
        }
        if (BOTH(6)) GRID_BAR(); PROBE_MARK(6);
    }

    {
        pg8::EpiEw<3> E{(pb*)(ws + WS_X1B), (const pb*)(ws + WS_XB), nullptr, nullptr, nullptr, nullptr, ssq, DM, nullptr, part, DM / 16};
        if (IN(7)) {
            pg8::Gemm g{(const pb*)(ws + WS_MRG), (const pb*)(ws + WS_WOUT), DM}; pg8::PanelOrder S; S.init(TOKP, DM, DM, F.G, (int)blockIdx.x, 16);
            pg8::gemm_phase<pg8::EpiEw<3>, pg8::PanelOrder, true, true>(F.lds + RING_OFF, g, S, E);
            if (BOTH(7)) GRID_BAR(); PROBE_MARK(7);
        }
        if (IN(8)) { E.finalize(16, gtid, gthreads); if (BOTH(8)) GRID_BAR(); PROBE_MARK(8); }
    }

    {
        pg8::EpiEw<4> E{(pb*)(ws + WS_U), nullptr, nullptr, nullptr, nullptr, nullptr, ssq, FFH, nullptr, part, DM / 4};
        if (IN(9)) {
#if defined(EXP_KLOOP) && EXP_KLOOP == 4
            const unsigned long long ck0 = __builtin_amdgcn_s_memtime(), rk0 = rt();
#endif
            pg8::Gemm g{(const pb*)(ws + WS_X1B), (const pb*)(ws + WS_WFFU), DM}; pg8::PanelOrder S; S.init(TOKP, FFH, DM, F.G, (int)blockIdx.x, 4, WGM_9);
            pg8::gemm_phase<pg8::EpiEw<4>, pg8::PanelOrder, true, true>(F.lds + RING_OFF, g, S, E);
#if defined(EXP_KLOOP) && EXP_KLOOP == 3
            { pg8::EpiNull EN; pg8::gemm_phase<pg8::EpiNull, pg8::PanelOrder, true, true>(F.lds + RING_OFF, g, S, EN); }
#endif
#if defined(EXP_KLOOP) && EXP_KLOOP == 4
            { const unsigned long long ck1 = __builtin_amdgcn_s_memtime(), rk1 = rt(); clk_mhz = (unsigned)((ck1 - ck0) * 100ull / (rk1 - rk0)); }
#endif
            if (BOTH(9)) GRID_BAR(); PROBE_MARK(9);
        }
        if (IN(10)) { E.finalize(4, gtid, gthreads); if (BOTH(10)) GRID_BAR(); PROBE_MARK(10); }
    }

    {
        pg8::EpiEw<5> E{(pb*)(ws + WS_X2B), nullptr, (const pb*)(ws + WS_X1B), nullptr, nullptr, nullptr, nullptr, DM, ws + WS_X2F8, part, FFH / 16};
        if (IN(11)) {
            pg8::Gemm g{(const pb*)(ws + WS_U), (const pb*)(ws + WS_WFFD), FFH}; pg8::PanelOrder S; S.init(TOKP, DM, FFH, F.G, (int)blockIdx.x, 16, WGM_11);
            pg8::gemm_phase<pg8::EpiEw<5>, pg8::PanelOrder, true, true>(F.lds + RING_OFF, g, S, E);
#if defined(EXP_KLOOP) && EXP_KLOOP == 3
            { pg8::EpiNull EN; pg8::gemm_phase<pg8::EpiNull, pg8::PanelOrder, true, true>(F.lds + RING_OFF, g, S, EN); }
#endif
            if (BOTH(11)) GRID_BAR(); PROBE_MARK(11);
        }
        if (IN(12)) { E.finalize(16, gtid, gthreads); if (BOTH(12)) GRID_BAR(); PROBE_MARK(12); }
    }

    {
        pg8::EpiEw<6> E{nullptr, (const pb*)(ws + WS_PP), (const pb*)(ws + WS_X2B), F.out, nullptr, nullptr, nullptr, DM, nullptr, part, 2048 / 8};
        if (IN(13)) {
            pg8::Gemm g{(const pb*)(ws + WS_X2F8), (const pb*)(ws + WS_WPG), DM / 2}; pg8::PanelOrder S; S.init(TOKP, DM, DM / 2, F.G, (int)blockIdx.x, 8);
            pg8::gemm_phase<pg8::EpiEw<6>, pg8::PanelOrder, true, true, true>(F.lds + RING_OFF, g, S, E);
            if (BOTH(13)) GRID_BAR(); PROBE_MARK(13);
        }
        if (IN(14)) { E.finalize(8, gtid, gthreads); }
    }
    PROBE_MARK(14);
#if defined(EXP_KLOOP) && EXP_KLOOP == 4
    { const unsigned long long t0 = rt(), tgt = (unsigned long long)clk_mhz * 100ull; while (rt() - t0 < tgt) __builtin_amdgcn_s_sleep(8); }
#endif
    if (PROBE_MASK) { const unsigned long long t0 = rt(), tgt = pr_acc * PROBE_REP; while (rt() - t0 < tgt) __builtin_amdgcn_s_sleep(8); }
#undef IN
#undef BOTH
#undef GRID_BAR
}

#ifndef MK_PER_PHASE
#define MK_PER_PHASE 0
#endif
extern "C" void kernel_launch(void* const* d_in, const int* in_sizes, int n_in, void* d_out, int out_size, void* d_ws, size_t ws_size, hipStream_t stream) {
    static int grid = 0;
    if (grid == 0) {
        if (n_in != 22 || out_size != (int)pg8::O_TOTAL || ws_size < WS_END) { fprintf(stderr, "kernel_launch: unexpected shapes (n_in %d out %d ws %zu need %zu)\n", n_in, out_size, ws_size, (size_t)WS_END); grid = -1; return; }
        int dev = 0, cus = 0, per_cu = 0;
        if (hipGetDevice(&dev) != hipSuccess || hipDeviceGetAttribute(&cus, hipDeviceAttributeMultiprocessorCount, dev) != hipSuccess) { grid = -1; return; }
        if (hipFuncSetAttribute((const void*)fwd_kernel, hipFuncAttributeMaxDynamicSharedMemorySize, LDS_BYTES) != hipSuccess) { grid = -1; return; }
        if (hipOccupancyMaxActiveBlocksPerMultiprocessor(&per_cu, (const void*)fwd_kernel, NWAVES * 64, LDS_BYTES) != hipSuccess || per_cu < 1) { fprintf(stderr, "kernel_launch: occupancy query says %d\n", per_cu); }
        (void)hipGetLastError();
        grid = cus;
    }
    if (grid < 0) return;
    if (hipMemsetAsync((char*)d_ws + WS_CTL, 0, CTL_ZERO_BYTES, stream) != hipSuccess) return;
    Args a;
    memset(&a, 0, sizeof(a));
    for (int i = 0; i < 22; ++i) a.in[i] = (const float*)d_in[i];
    a.out = (float*)d_out; a.ws = (unsigned char*)d_ws;
#if MK_PER_PHASE
    for (int p = 0; p < 15; ++p) { a.ph_lo = p; a.ph_hi = p + 1; hipLaunchKernelGGL(fwd_kernel, dim3(grid), dim3(NWAVES * 64), LDS_BYTES, stream, a); }
#else
    a.ph_lo = 0; a.ph_hi = 15;
    hipLaunchKernelGGL(fwd_kernel, dim3(grid), dim3(NWAVES * 64), LDS_BYTES, stream, a);
#endif
}
```

```cpp
#include <hip/hip_runtime.h>
#include <cstdio>
#include <cstdint>
#include <cstring>

__device__ __forceinline__ void fin_wait(unsigned* cnt, unsigned* tmo, unsigned G) {
    if (threadIdx.x == 0) {
        unsigned sp = 0u;
        while (__hip_atomic_load(cnt, __ATOMIC_RELAXED, __HIP_MEMORY_SCOPE_AGENT) < G) {
            __builtin_amdgcn_s_sleep(1);
            if ((++sp & 255u) == 0u) { if (__hip_atomic_load(tmo, __ATOMIC_RELAXED, __HIP_MEMORY_SCOPE_AGENT)) break; if (sp > (1u << 18)) { atomicAdd(tmo, 1u); break; } }
        }
        __builtin_amdgcn_fence(__ATOMIC_ACQUIRE, "agent");
        asm volatile("s_waitcnt vmcnt(0)" ::: "memory");
    }
    __syncthreads();
}
namespace pg8 {
#define PG8_LAS __attribute__((address_space(3)))
typedef unsigned short bf16_t;
typedef short bf16x8 __attribute__((ext_vector_type(8)));
typedef float f32x4 __attribute__((ext_vector_type(4)));
typedef unsigned u32x4 __attribute__((ext_vector_type(4)));
typedef int i32x4_t __attribute__((ext_vector_type(4)));
constexpr int BM = 256, BK = 64, HALF = 128, HTB = HALF * BK * 2  , STAGE_BYTES = 8 * HTB, NXCD = 8, WGM = 4;

__host__ __device__ __forceinline__ int lds_byte(int r, int c) { const int st = (r >> 4) * 2 + (c >> 5), rr = r & 15, cc = c & 31, ob = rr * 64 + cc * 2; return st * 1024 + (ob ^ (((ob >> 9) & 1) << 5)); }
__host__ __device__ __forceinline__ void stage_rc(int b, int& R, int& C) { const int st = b / 1024, sb = b % 1024, swz = sb ^ (((sb >> 9) & 1) << 5); R = (st >> 1) * 16 + swz / 64; C = (st & 1) * 32 + (swz % 64) / 2; }
__host__ __device__ __forceinline__ int perm32(int rho) { const int n = rho >> 4, i = rho & 15; return 8 * (i >> 2) + 4 * n + (i & 3); }

struct Unit { int pm, pn, kb, nt; };
struct Gemm { const bf16_t* A; const bf16_t* Bt; int ld; };

struct StaticOrder {
    int nM, nN, nwg, G, c, ntf, wgm;
    __host__ __device__ void init(int M, int N, int K, int G_, int c_, int wgm_ = WGM) { nM = M / BM; nN = N / BM; nwg = nM * nN; G = G_; c = c_; ntf = K / BK; wgm = wgm_; }
    __host__ __device__ bool next(int i, Unit& u) const {
        const long L = (long)i * G + c; if (L >= nwg) return false;
        int wgid = (int)L; { const int q = nwg / NXCD, r = nwg % NXCD, xcd = wgid % NXCD, off = wgid / NXCD; wgid = (xcd < r ? xcd * (q + 1) : r * (q + 1) + (xcd - r) * q) + off; }
        const int nig = wgm * nN, gid = wgid / nig, fm = gid * wgm, gsz = (nM - fm) < wgm ? (nM - fm) : wgm;
        u.pm = fm + ((wgid % nig) % gsz); u.pn = (wgid % nig) / gsz; u.kb = 0; u.nt = ntf; return true;
    }
    __device__ __forceinline__ void a_ready(const Unit&) const {}
    __device__ __forceinline__ void done(const Unit&) const {}
};

struct PanelOrder {
    int nMp, nN, nwg, G, c, ntf, splits, nts, wgm; unsigned* fin; unsigned* tmo;
    __host__ __device__ void init(int Mp, int N, int K, int G_, int c_, int splits_, int wgm_ = WGM) { wgm = wgm_; nMp = Mp / BM; nN = N / BM; nwg = nMp * nN; G = G_; c = c_; ntf = K / BK; splits = splits_; nts = splits_ ? ntf / splits_ : 0; fin = nullptr; tmo = nullptr; }
    __host__ __device__ bool next(int i, Unit& u) const {
        const bool pf = (c & 1) && (nwg % G == 0) && (nwg >= G) && (nN * splits <= G);
        int s = -1; long L = (long)i * G + c;
        if (pf && c < nN * splits) { if (i == 1) s = c; else if (i > 1) L = (long)(i - 1) * G + c; }
        if (s < 0) {
            if (L < nwg) {
                int wgid = (int)L; { const int q = nwg / NXCD, r = nwg % NXCD, xcd = wgid % NXCD, off = wgid / NXCD; wgid = (xcd < r ? xcd * (q + 1) : r * (q + 1) + (xcd - r) * q) + off; }
                const int nig = wgm * nN, gid = wgid / nig, fm = gid * wgm, gsz = (nMp - fm) < wgm ? (nMp - fm) : wgm;
                u.pm = fm + ((wgid % nig) % gsz); u.pn = (wgid % nig) / gsz; u.kb = 0; u.nt = ntf; return true;
            }
            if (pf) return false;
            s = (int)(L - nwg); if (s >= nN * splits) return false;
        }
        u.pm = nMp; u.pn = s % nN; u.kb = (s / nN) * nts * BK; u.nt = nts; return true;
    }
    __device__ __forceinline__ void a_ready(const Unit& u) const { if (fin && u.pm == nMp) ::fin_wait(fin, tmo, (unsigned)G); }
    __device__ __forceinline__ void done(const Unit&) const {}
};

struct TailOrder {
    int nM, nN, nwg, G, c, ntf, n4, lo, hi, wgm;
    __host__ __device__ void init(int M, int N, int K, int G_, int c_, int n4_, int lo_, int hi_, int wgm_ = WGM) { wgm = wgm_; nM = M / BM; nN = N / BM; nwg = nM * nN; G = G_; c = c_; ntf = K / BK; n4 = n4_; lo = lo_; hi = hi_; }
    __host__ __device__ bool next(int i, Unit& u) const {
        long L;
        if (i < n4) L = (long)i * G + c; else if (i == n4 && c >= lo && c < hi) L = (long)n4 * G + (c - lo); else return false;
        if (L >= nwg) return false;
        int wgid = (int)L; { const int q = nwg / NXCD, r = nwg % NXCD, xcd = wgid % NXCD, off = wgid / NXCD; wgid = (xcd < r ? xcd * (q + 1) : r * (q + 1) + (xcd - r) * q) + off; }
        const int nig = wgm * nN, gid = wgid / nig, fm = gid * wgm, gsz = (nM - fm) < wgm ? (nM - fm) : wgm;
        u.pm = fm + ((wgid % nig) % gsz); u.pn = (wgid % nig) / gsz; u.kb = 0; u.nt = ntf; return true;
    }
    __device__ __forceinline__ void a_ready(const Unit&) const {}
    __device__ __forceinline__ void done(const Unit&) const {}
};

struct RangeOrder {
    int nM, nN, nwg, ntf, base, cnt, wgm;
    __host__ __device__ void init(int M, int N, int K, int base_, int cnt_, int wgm_ = WGM) { wgm = wgm_; nM = M / BM; nN = N / BM; nwg = nM * nN; ntf = K / BK; base = base_; cnt = cnt_; }
    __host__ __device__ bool next(int i, Unit& u) const {
        if (i >= cnt || base + i >= nwg) return false;
        int wgid = base + i; { const int q = nwg / NXCD, r = nwg % NXCD, xcd = wgid % NXCD, off = wgid / NXCD; wgid = (xcd < r ? xcd * (q + 1) : r * (q + 1) + (xcd - r) * q) + off; }
        const int nig = wgm * nN, gid = wgid / nig, fm = gid * wgm, gsz = (nM - fm) < wgm ? (nM - fm) : wgm;
        u.pm = fm + ((wgid % nig) % gsz); u.pn = (wgid % nig) / gsz; u.kb = 0; u.nt = ntf; return true;
    }
    __device__ __forceinline__ void a_ready(const Unit&) const {}
    __device__ __forceinline__ void done(const Unit&) const {}
};

__device__ __forceinline__ unsigned cvt_pk_bf16(float lo, float hi) { unsigned r; asm volatile("v_cvt_pk_bf16_f32 %0, %1, %2" : "=v"(r) : "v"(lo), "v"(hi)); return r; }
__device__ __forceinline__ float sigm(float x) { return __builtin_amdgcn_rcpf(1.0f + __expf(-x)); }
__device__ __forceinline__ void st_bf16x8(bf16_t* p, const f32x4 a, const f32x4 b) {
    u32x4 w; w.x = cvt_pk_bf16(a[0], a[1]); w.y = cvt_pk_bf16(a[2], a[3]); w.z = cvt_pk_bf16(b[0], b[1]); w.w = cvt_pk_bf16(b[2], b[3]); *(u32x4*)p = w; }
__device__ __forceinline__ void ld_bf16x8(const bf16_t* p, f32x4& a, f32x4& b) {
    const u32x4 w = *(const u32x4*)p;
    a[0] = __uint_as_float(w.x << 16); a[1] = __uint_as_float(w.x & 0xffff0000u); a[2] = __uint_as_float(w.y << 16); a[3] = __uint_as_float(w.y & 0xffff0000u);
    b[0] = __uint_as_float(w.z << 16); b[1] = __uint_as_float(w.z & 0xffff0000u); b[2] = __uint_as_float(w.w << 16); b[3] = __uint_as_float(w.w & 0xffff0000u); }
__device__ __forceinline__ f32x4 sigm4(const f32x4 v) { f32x4 o; o[0] = sigm(v[0]); o[1] = sigm(v[1]); o[2] = sigm(v[2]); o[3] = sigm(v[3]); return o; }

constexpr int TOK_P = 8192, TOK_ALL = 8448;
constexpr float NEPS = 1e-6f;
constexpr size_t O_Y = 0, O_KV128P = 34603008, O_KV512P = 34865152, O_KV2048P = 35913728, O_STP = 40108032,
                 O_KV128S = 40370176, O_KV512S = 40894464, O_KV2048S = 41418752, O_STS = 41943040, O_TOTAL = 50331648;

__device__ __forceinline__ void kv_store(float* out, int g, int row, int kvsel, int hd, const f32x4 a, const f32x4 b) {
    float* dst;
    if (row >= TOK_P) {
        const size_t base = g == 0 ? O_KV128S : (g == 1 ? O_KV512S : O_KV2048S);
        dst = out + base + ((size_t)(row - TOK_P) * 2 + kvsel) * 1024 + hd;
    } else {
        const int L = 128 << (2 * g);
        if (row < TOK_P - L) return;
        const size_t base = g == 0 ? O_KV128P : (g == 1 ? O_KV512P : O_KV2048P);
        dst = out + base + ((size_t)(row - (TOK_P - L)) * 2 + kvsel) * 1024 + hd;
    }
    *(f32x4*)dst = a; *(f32x4*)(dst + 4) = b;
}

struct EpiIn {
    static constexpr bool PERM = true, AFTER_DRAIN = false;
    bf16_t *Q, *K, *V, *HQ, *KK, *HI, *OG, *SA, *SB; float* LG;
    const float *r0, *gq, *gk, *lbraw; float* out; PG8_LAS float* tab;
    int pn_off; float ascale; int pn_split;
    __device__ __forceinline__ void operator()(const f32x4 (&acc)[2][2][4][2], const Unit& u, int wr, int wc, int fr_, int fq_) const {
        int tz = threadIdx.x; asm volatile("" : "+v"(tz));
        const int fr = tz & 15, fq = (tz >> 4) & 3;
        const int pn = u.pn < pn_split ? u.pn : u.pn + pn_off;
        const int row0 = u.pm * BM + wr * 64 + fr;
        const int cl = wc * 32 + 8 * fq;
        float rsv[2][4];
#pragma unroll
        for (int ai = 0; ai < 2; ++ai)
#pragma unroll
            for (int m = 0; m < 4; ++m) rsv[ai][m] = r0[row0 + ai * HALF + m * 16] * ascale;
        if (pn < 24) {
            const bool isk = pn >= 12;
            const int cb = (isk ? pn - 12 : pn) * 256;
            const float* gain = isk ? gk : gq;
            f32x4 gv[2][2];
#pragma unroll
            for (int bj = 0; bj < 2; ++bj) { const int g = (cb + bj * HALF) >> 10; gv[bj][0] = *(const f32x4*)(gain + g * 128 + cl); gv[bj][1] = *(const f32x4*)(gain + g * 128 + cl + 4); }
            float sq[2][4][2];
#pragma unroll
            for (int ai = 0; ai < 2; ++ai)
#pragma unroll
                for (int m = 0; m < 4; ++m) {
                    const float rs = rsv[ai][m];
#pragma unroll
                    for (int bj = 0; bj < 2; ++bj) {
                        const f32x4 a = acc[ai][bj][m][0] * rs, b = acc[ai][bj][m][1] * rs;
                        sq[ai][m][bj] = (a[0] * a[0] + a[1] * a[1]) + (a[2] * a[2] + a[3] * a[3]) + (b[0] * b[0] + b[1] * b[1]) + (b[2] * b[2] + b[3] * b[3]);
                    }
                }
#pragma unroll
            for (int st = 16; st <= 32; st <<= 1)
#pragma unroll
                for (int ai = 0; ai < 2; ++ai)
#pragma unroll
                    for (int m = 0; m < 4; ++m)
#pragma unroll
                        for (int bj = 0; bj < 2; ++bj) sq[ai][m][bj] += __shfl_xor(sq[ai][m][bj], st);
            if (fq == 0) {
#pragma unroll
                for (int ai = 0; ai < 2; ++ai)
#pragma unroll
                    for (int m = 0; m < 4; ++m)
#pragma unroll
                        for (int bj = 0; bj < 2; ++bj) tab[((ai * HALF + wr * 64 + m * 16 + fr) * 2 + bj) * 4 + wc] = sq[ai][m][bj];
            }
            asm volatile("s_waitcnt lgkmcnt(0)" ::: "memory"); __builtin_amdgcn_s_barrier(); asm volatile("" ::: "memory");
#pragma unroll
            for (int ai = 0; ai < 2; ++ai)
#pragma unroll
                for (int m = 0; m < 4; ++m) {
                    const int row = row0 + ai * HALF + m * 16;
                    const float rs = rsv[ai][m];
#pragma unroll
                    for (int bj = 0; bj < 2; ++bj) {
                        const f32x4 t = *(const PG8_LAS f32x4*)&tab[((ai * HALF + wr * 64 + m * 16 + fr) * 2 + bj) * 4];
                        const float sc = rs * rsqrtf(((t[0] + t[1]) + (t[2] + t[3])) * (1.0f / 128.0f) + NEPS);
                        const int col = cb + bj * HALF + cl;
                        const int g = col >> 10;
                        const f32x4 a = acc[ai][bj][m][0] * sc * gv[bj][0], b = acc[ai][bj][m][1] * sc * gv[bj][1];
                        st_bf16x8((isk ? K : Q) + (size_t)row * 3072 + col, a, b);
                        if (isk) kv_store(out, g, row, 0, col & 1023, a, b);
                    }
                }
            return;
        }
        f32x4 lbv[2][2];
        if (pn >= 44 && pn < 52) {
#pragma unroll
            for (int bj = 0; bj < 2; ++bj)
#pragma unroll
                for (int hf = 0; hf < 2; ++hf) { const int col = (pn - 44) * 256 + bj * HALF + cl + 4 * hf; const f32x4 l0 = *(const f32x4*)(lbraw + col), l1 = *(const f32x4*)(lbraw + 2048 + col);
#pragma unroll
                    for (int j = 0; j < 4; ++j) lbv[bj][hf][j] = __builtin_amdgcn_rcpf(1.0f + __expf(l1[j] - l0[j])); }
        }
#pragma unroll
        for (int ai = 0; ai < 2; ++ai)
#pragma unroll
            for (int m = 0; m < 4; ++m) {
                const int row = row0 + ai * HALF + m * 16;
                const float rs = rsv[ai][m];
#pragma unroll
                for (int bj = 0; bj < 2; ++bj) {
                    f32x4 a = acc[ai][bj][m][0] * rs, b = acc[ai][bj][m][1] * rs;
                    const int ct = bj * HALF + cl;
                    if (pn < 36) {
                        const int col = (pn - 24) * 256 + ct;
                        st_bf16x8(V + (size_t)row * 3072 + col, a, b);
                        kv_store(out, col >> 10, row, 1, col & 1023, a, b);
                    } else if (pn < 44) {
                        const int col = (pn - 36) * 256 + ct;
                        a = a * sigm4(a) * 0.08838834764831845f; b = b * sigm4(b) * 0.08838834764831845f;
                        st_bf16x8(HQ + (size_t)row * 2048 + col, a, b);
                    } else if (pn < 52) {
                        const int col = (pn - 44) * 256 + ct;
                        f32x4 lga, lgb, ka, kb;
#pragma unroll
                        for (int j = 0; j < 4; ++j) {
                            const float lba = lbv[bj][0][j], lbb = lbv[bj][1][j];
                            const float sa_ = sigm(a[j]), sb_ = sigm(b[j]);
                            lga[j] = __logf(lba + (1.0f - lba) * sa_); lgb[j] = __logf(lbb + (1.0f - lbb) * sb_);
                            ka[j] = (1.0f - lba) * sigm(-a[j]); kb[j] = (1.0f - lbb) * sigm(-b[j]);
                        }
                        float* lp = LG + (size_t)row * 2048 + col; *(f32x4*)lp = lga; *(f32x4*)(lp + 4) = lgb;
                        st_bf16x8(KK + (size_t)row * 2048 + col, ka, kb);
                    } else if (pn < 60) {
                        const int col = (pn - 52) * 256 + ct;
                        st_bf16x8(HI + (size_t)row * 2048 + col, a, b);
                    } else if (pn < 68) {
                        const int col = (pn - 60) * 256 + ct;
                        st_bf16x8(OG + (size_t)row * 2048 + col, sigm4(a), sigm4(b));
                    } else if (pn < 84) {
                        const int col = (pn - 68) * 256 + ct;
                        st_bf16x8(SA + (size_t)row * 4096 + col, sigm4(a), sigm4(b));
                    } else {
                        const int col = (pn - 84) * 256 + ct;
                        st_bf16x8(SB + (size_t)row * 4096 + col, sigm4(a), sigm4(b));
                    }
                }
            }
    }
};

template <int KIND> struct EpiEw {
    static constexpr bool PERM = true, AFTER_DRAIN = false;
    bf16_t* O; const bf16_t* G1; const bf16_t* O2; float* F; const float* XP; const float* XS; float* ssq; int ldc;
    unsigned char* O8;
    float* part; int kchunk;
    __device__ __forceinline__ float rowscale(int row) const { return KIND == 4 ? rsqrtf(ssq[row] * (1.0f / 4096.0f) + NEPS) : 0.f; }
    struct Ld { u32x4 g, o2; };
    __device__ __forceinline__ void load8(int row, int col, Ld& L) const {
        const size_t off = (size_t)row * ldc + col;
        if (KIND == 1 || KIND == 2 || KIND == 3 || KIND == 6) L.g = *(const u32x4*)(G1 + off);
        if (KIND == 2 || KIND == 5 || KIND == 6) L.o2 = *(const u32x4*)(O2 + off);
    }
    static __device__ __forceinline__ void unpk(const u32x4 w, f32x4& a, f32x4& b) {
        a[0] = __uint_as_float(w.x << 16); a[1] = __uint_as_float(w.x & 0xffff0000u); a[2] = __uint_as_float(w.y << 16); a[3] = __uint_as_float(w.y & 0xffff0000u);
        b[0] = __uint_as_float(w.z << 16); b[1] = __uint_as_float(w.z & 0xffff0000u); b[2] = __uint_as_float(w.w << 16); b[3] = __uint_as_float(w.w & 0xffff0000u); }
    __device__ __forceinline__ float apply8(int row, int col, f32x4 a, f32x4 b, float rs, const Ld& L) const {
        const size_t off = (size_t)row * ldc + col; float ss = 0.f;
        if (KIND == 0) { st_bf16x8(O + off, a, b); }
        if (KIND == 1) { f32x4 ga, gb; unpk(L.g, ga, gb); st_bf16x8(O + off, a * ga, b * gb); }
        if (KIND == 2) { f32x4 ga, gb, pa, pb; unpk(L.g, ga, gb); unpk(L.o2, pa, pb); st_bf16x8(O + off, pa + a * ga, pb + b * gb); }
        if (KIND == 3) {
            f32x4 xa, xb; unpk(L.g, xa, xb); a += xa; b += xb; st_bf16x8(O + off, a, b);
            ss = (a[0] * a[0] + a[1] * a[1]) + (a[2] * a[2] + a[3] * a[3]) + (b[0] * b[0] + b[1] * b[1]) + (b[2] * b[2] + b[3] * b[3]);
        }
        if (KIND == 4) {
#pragma unroll
            for (int j = 0; j < 4; ++j) { const float x = fmaxf(a[j] * rs, 0.f), y = fmaxf(b[j] * rs, 0.f); a[j] = x * x; b[j] = y * y; }
            st_bf16x8(O + off, a, b);
        }
        if (KIND == 5) { f32x4 xa, xb; unpk(L.o2, xa, xb); a += xa; b += xb; st_bf16x8(O + off, a, b);
            if (O8) { int w0 = __builtin_amdgcn_cvt_pk_fp8_f32(a[0], a[1], 0, false); w0 = __builtin_amdgcn_cvt_pk_fp8_f32(a[2], a[3], w0, true);
                int w1 = __builtin_amdgcn_cvt_pk_fp8_f32(b[0], b[1], 0, false); w1 = __builtin_amdgcn_cvt_pk_fp8_f32(b[2], b[3], w1, true);
                typedef int i32x2_t __attribute__((ext_vector_type(2))); *(i32x2_t*)(O8 + off) = (i32x2_t){w0, w1}; } }
        if (KIND == 6) { f32x4 ga, gb, xa, xb; unpk(L.g, ga, gb); unpk(L.o2, xa, xb); a = xa + sigm4(a * 0.015625f) * ga; b = xb + sigm4(b * 0.015625f) * gb;
            *(f32x4*)(F + off) = a; *(f32x4*)(F + off + 4) = b; }
        return ss;
    }
    __device__ __forceinline__ void operator()(const f32x4 (&acc)[2][2][4][2], const Unit& u, int wr, int wc, int fr_, int fq_) const {
        int tz = threadIdx.x; asm volatile("" : "+v"(tz));
        const int fr = tz & 15, fq = (tz >> 4) & 3;
        const int row0 = u.pm * BM + wr * 64 + fr;
        const int col0 = u.pn * BM + wc * 32 + 8 * fq;
        if (part != nullptr && u.pm == TOK_P / BM) {
            float* pb = part + ((size_t)(u.kb / kchunk) * 256 + (row0 - TOK_P)) * ldc + col0;
#pragma unroll
            for (int ai = 0; ai < 2; ++ai)
#pragma unroll
                for (int m = 0; m < 4; ++m)
#pragma unroll
                    for (int bj = 0; bj < 2; ++bj) { float* p = pb + (size_t)(ai * HALF + m * 16) * ldc + bj * HALF; *(f32x4*)p = acc[ai][bj][m][0]; *(f32x4*)(p + 4) = acc[ai][bj][m][1]; }
            return;
        }
        float rsv[2][4];
        if (KIND == 4) {
#pragma unroll
            for (int ai = 0; ai < 2; ++ai)
#pragma unroll
                for (int m = 0; m < 4; ++m) rsv[ai][m] = ssq[row0 + ai * HALF + m * 16];
        }
        constexpr int MB = (KIND == 6) ? 1 : 2, NB = 8 / MB;
        Ld L[2][MB][2];
#define EPI_LOAD(B_) do { _Pragma("unroll") for (int mm = 0; mm < MB; ++mm) { const int q_ = (B_) * MB + mm; _Pragma("unroll") for (int bj = 0; bj < 2; ++bj) \
            load8(row0 + (q_ >> 2) * HALF + (q_ & 3) * 16, col0 + bj * HALF, L[(B_) & 1][mm][bj]); } } while (0)
        EPI_LOAD(0);
#pragma unroll
        for (int bt = 0; bt < NB; ++bt) {
            if (bt + 1 < NB) EPI_LOAD(bt + 1);
#pragma unroll
            for (int mm = 0; mm < MB; ++mm) {
                const int q = bt * MB + mm, ai = q >> 2, m = q & 3, row = row0 + ai * HALF + m * 16;
                const float rs = KIND == 4 ? rsqrtf(rsv[ai][m] * (1.0f / 4096.0f) + NEPS) : 0.f;
                float ss = 0.f;
#pragma unroll
                for (int bj = 0; bj < 2; ++bj) ss += apply8(row, col0 + bj * HALF, acc[ai][bj][m][0], acc[ai][bj][m][1], rs, L[bt & 1][mm][bj]);
                if (KIND == 3) { ss += __shfl_xor(ss, 16); ss += __shfl_xor(ss, 32); if (fq == 0) atomicAdd(ssq + row, ss); }
            }
        }
#undef EPI_LOAD
    }
    __device__ __forceinline__ void finalize(int nsplit, int gtid, int gthreads) const {
        const int per_row = ldc / 8;
        for (int it = gtid; it < 256 * per_row; it += gthreads) {
            const int rs_ = it / per_row, c8 = it - rs_ * per_row;
            f32x4 a = {0.f, 0.f, 0.f, 0.f}, b = a;
            for (int sp = 0; sp < nsplit; ++sp) { const float* p = part + ((size_t)sp * 256 + rs_) * ldc + c8 * 8; a += *(const f32x4*)p; b += *(const f32x4*)(p + 4); }
            const int row = TOK_P + rs_;
            Ld L; load8(row, c8 * 8, L);
            float ss = apply8(row, c8 * 8, a, b, rowscale(row), L);
            if (KIND == 3) {
#pragma unroll
                for (int o = 1; o < 64; o <<= 1) ss += __shfl_xor(ss, o);
                if ((threadIdx.x & 63) == 0) atomicAdd(ssq + row, ss);
            }
        }
    }
};

struct EpiNull {
    static constexpr bool PERM = true, AFTER_DRAIN = false;
    __device__ __forceinline__ void operator()(const f32x4 (&acc)[2][2][4][2], const Unit& u, int wr, int wc, int fr, int fq) const {
#pragma unroll
        for (int ai = 0; ai < 2; ++ai)
#pragma unroll
            for (int bj = 0; bj < 2; ++bj)
#pragma unroll
                for (int m = 0; m < 4; ++m) { asm volatile("" :: "v"(acc[ai][bj][m][0]), "v"(acc[ai][bj][m][1])); }
    }
};

template <class Epi, class Sched, bool ALIGN_EPI = false, bool SP2 = false, bool F8 = false>
__device__ __forceinline__ void gemm_phase(PG8_LAS unsigned char* lds, const Gemm g, const Sched& S, const Epi& E) {
    const int tid = threadIdx.x, wid = __builtin_amdgcn_readfirstlane(tid >> 6), lane = tid & 63, wr = wid >> 2, wc = wid & 3, fr = lane & 15, fq = lane >> 4;
    const int K = g.ld;
    unsigned voffA[2], voffB[2];
#pragma unroll
    for (int i = 0; i < 2; ++i) { int R, C; stage_rc(tid * 16 + i * 8192, R, C); const int Rb = Epi::PERM ? ((R & ~31) + perm32(R & 31)) : R;
        voffA[i] = (unsigned)(R * K + C) * 2u; voffB[i] = (unsigned)(Rb * K + C) * 2u; }
    const size_t kstep = (size_t)(BK * 2);
    const size_t hstep = (size_t)HALF * K * 2;
    const size_t tstep = 2 * hstep;
    const unsigned ldsw = (unsigned)wid * 1024u;
    const int aoff = lds_byte(wr * 64 + fr, fq * 8), boff = lds_byte(wc * 32 + fr, fq * 8);
#define PG8_SA(b, h) (((b) * 2 + (h)) * HTB)
#define PG8_SB(b, h) ((4 + (b) * 2 + (h)) * HTB)
#define PG8_STAGE(bufoff, gbase, voff) do { _Pragma("unroll") for (int _i = 0; _i < 2; ++_i) \
        __builtin_amdgcn_global_load_lds((const unsigned*)((const char*)(gbase) + (voff)[_i]), (PG8_LAS unsigned*)(lds + (bufoff) + ldsw + _i * 8192), 16, 0, 0); } while (0)
#define PG8_LDA(dst, b, h) do { _Pragma("unroll") for (int m = 0; m < 4; ++m) _Pragma("unroll") for (int k = 0; k < 2; ++k) dst[m][k] = *(const PG8_LAS bf16x8*)(lds + PG8_SA(b, h) + aoff + m * 2048 + k * 1024); } while (0)
#define PG8_LDB(dst, b, h) do { _Pragma("unroll") for (int n = 0; n < 2; ++n) _Pragma("unroll") for (int k = 0; k < 2; ++k) dst[n][k] = *(const PG8_LAS bf16x8*)(lds + PG8_SB(b, h) + boff + n * 2048 + k * 1024); } while (0)
#define PG8_MMA(ai, bj, At, Bt) do { __builtin_amdgcn_s_setprio(1); _Pragma("unroll") for (int m = 0; m < 4; ++m) _Pragma("unroll") for (int n = 0; n < 2; ++n) { \
        if constexpr (F8) { asm volatile("v_mfma_scale_f32_16x16x128_f8f6f4 %0, %1, %2, %0, %3, %3 op_sel_hi:[0,0,0]" : "+v"(acc[ai][bj][m][n]) \
                : "v"(__builtin_shufflevector(__builtin_bit_cast(i32x4_t, Bt[n][0]), __builtin_bit_cast(i32x4_t, Bt[n][1]), 0, 1, 2, 3, 4, 5, 6, 7)), \
                  "v"(__builtin_shufflevector(__builtin_bit_cast(i32x4_t, At[m][0]), __builtin_bit_cast(i32x4_t, At[m][1]), 0, 1, 2, 3, 4, 5, 6, 7)), "v"(f8scale)); } \
        else { _Pragma("unroll") for (int k = 0; k < 2; ++k) acc[ai][bj][m][n] = __builtin_amdgcn_mfma_f32_16x16x32_bf16(Bt[n][k], At[m][k], acc[ai][bj][m][n], 0, 0, 0); } } \
        __builtin_amdgcn_s_setprio(0); } while (0)
#define PG8_WAIT_V(n) asm volatile("s_waitcnt vmcnt(" #n ")" ::: "memory")
#define PG8_WAIT_L(n) asm volatile("s_waitcnt lgkmcnt(" #n ")" ::: "memory")
#define PG8_BAR __builtin_amdgcn_s_barrier()
#define PG8_SCHED __builtin_amdgcn_sched_barrier(0)
    Unit cur, nxt; int ui = 0;
    if (!S.next(0, cur)) return;
    f32x4 acc[2][2][4][2];
#pragma unroll
    for (int a = 0; a < 2; ++a)
#pragma unroll
        for (int b = 0; b < 2; ++b)
#pragma unroll
            for (int m = 0; m < 4; ++m)
#pragma unroll
                for (int n = 0; n < 2; ++n) acc[a][b][m][n] = (f32x4){0.f, 0.f, 0.f, 0.f};
    bf16x8 At[4][2], B0[2][2], B1[2][2];
    const int f8scale = 0x7f7f7f7f;
    int nt = cur.nt;
    const char* cA = (const char*)g.A + (size_t)cur.pm * tstep + (size_t)cur.kb * 2; const char* cB = (const char*)g.Bt + (size_t)cur.pn * tstep + (size_t)cur.kb * 2;
    S.a_ready(cur);
    if constexpr (SP2) {
        PG8_STAGE(PG8_SB(0, 0), cB, voffB); PG8_STAGE(PG8_SB(0, 1), cB + hstep, voffB); PG8_STAGE(PG8_SA(0, 0), cA, voffA); PG8_STAGE(PG8_SA(0, 1), cA + hstep, voffA);
        if (wr == 1) PG8_BAR;
        PG8_WAIT_V(2); PG8_BAR;
        PG8_STAGE(PG8_SB(1, 0), cB + kstep, voffB); PG8_STAGE(PG8_SA(1, 0), cA + kstep, voffA); PG8_STAGE(PG8_SB(1, 1), cB + hstep + kstep, voffB);
        PG8_WAIT_V(6); PG8_BAR;
    } else {
        PG8_STAGE(PG8_SB(0, 0), cB, voffB); PG8_STAGE(PG8_SA(0, 0), cA, voffA); PG8_STAGE(PG8_SB(0, 1), cB + hstep, voffB); PG8_STAGE(PG8_SA(0, 1), cA + hstep, voffA);
        if (wr == 1) PG8_BAR;
        PG8_WAIT_V(4); PG8_BAR;
        PG8_STAGE(PG8_SB(1, 0), cB + kstep, voffB); PG8_STAGE(PG8_SA(1, 0), cA + kstep, voffA); PG8_STAGE(PG8_SB(1, 1), cB + hstep + kstep, voffB);
        PG8_WAIT_V(6); PG8_BAR;
    }
    for (;;) {
        const bool has_next = S.next(ui + 1, nxt);
        const char* nA = has_next ? (const char*)g.A + (size_t)nxt.pm * tstep + (size_t)nxt.kb * 2 : cA; const char* nB = has_next ? (const char*)g.Bt + (size_t)nxt.pn * tstep + (size_t)nxt.kb * 2 : cB;
        for (int t = 0; t < nt; t += 2) {
            const bool last = (t == nt - 2);
            const char* a1 = cA + (size_t)(t + 1) * kstep;
            const char* a2 = last ? nA : cA + (size_t)(t + 2) * kstep; const char* b2 = last ? nB : cB + (size_t)(t + 2) * kstep;
            const char* a3 = a2 + kstep; const char* b3 = b2 + kstep;
            if (last && has_next) S.a_ready(nxt);
            if constexpr (SP2) {
            PG8_LDB(B0, 0, 0); PG8_LDB(B1, 0, 1); PG8_SCHED; PG8_LDA(At, 0, 0); PG8_STAGE(PG8_SA(1, 1), a1 + hstep, voffA);
            PG8_WAIT_V(8); PG8_WAIT_L(0); PG8_BAR; PG8_MMA(0, 0, At, B0); PG8_MMA(0, 1, At, B1); PG8_BAR; PG8_SCHED;
            PG8_LDA(At, 0, 1); PG8_STAGE(PG8_SB(0, 0), b2, voffB); PG8_STAGE(PG8_SB(0, 1), b2 + hstep, voffB); PG8_STAGE(PG8_SA(0, 0), a2, voffA);
            PG8_WAIT_V(8); PG8_WAIT_L(0); PG8_BAR; PG8_MMA(1, 0, At, B0); PG8_MMA(1, 1, At, B1); PG8_BAR; PG8_SCHED;
            PG8_LDB(B0, 1, 0); PG8_LDB(B1, 1, 1); PG8_SCHED; PG8_LDA(At, 1, 0); PG8_STAGE(PG8_SA(0, 1), a2 + hstep, voffA);
            PG8_WAIT_V(8); PG8_WAIT_L(0); PG8_BAR; PG8_MMA(0, 0, At, B0); PG8_MMA(0, 1, At, B1); PG8_BAR; PG8_SCHED;
            PG8_LDA(At, 1, 1); PG8_STAGE(PG8_SB(1, 0), b3, voffB); PG8_STAGE(PG8_SB(1, 1), b3 + hstep, voffB); PG8_STAGE(PG8_SA(1, 0), a3, voffA);
            PG8_WAIT_V(8); PG8_WAIT_L(0); PG8_BAR; PG8_MMA(1, 0, At, B0); PG8_MMA(1, 1, At, B1); PG8_BAR; PG8_SCHED;
            } else {
            PG8_LDB(B0, 0, 0); PG8_SCHED; PG8_LDA(At, 0, 0); PG8_STAGE(PG8_SA(1, 1), a1 + hstep, voffA);
            PG8_WAIT_L(8); PG8_BAR; PG8_WAIT_L(0); PG8_MMA(0, 0, At, B0); PG8_BAR; PG8_SCHED;
            PG8_LDB(B1, 0, 1); PG8_STAGE(PG8_SB(0, 0), b2, voffB);
            PG8_BAR; PG8_WAIT_L(0); PG8_MMA(0, 1, At, B1); PG8_BAR;
            PG8_LDA(At, 0, 1); PG8_STAGE(PG8_SA(0, 0), a2, voffA);
            PG8_BAR; PG8_WAIT_L(0); PG8_MMA(1, 0, At, B0); PG8_BAR; PG8_SCHED;
            PG8_STAGE(PG8_SB(0, 1), b2 + hstep, voffB);
            PG8_WAIT_V(6); PG8_BAR; PG8_MMA(1, 1, At, B1); PG8_BAR;
            PG8_LDB(B0, 1, 0); PG8_SCHED; PG8_LDA(At, 1, 0); PG8_STAGE(PG8_SA(0, 1), a2 + hstep, voffA);
            PG8_WAIT_L(8); PG8_BAR; PG8_WAIT_L(0); PG8_MMA(0, 0, At, B0); PG8_BAR; PG8_SCHED;
            PG8_LDB(B1, 1, 1); PG8_STAGE(PG8_SB(1, 0), b3, voffB);
            PG8_BAR; PG8_WAIT_L(0); PG8_MMA(0, 1, At, B1); PG8_BAR;
            PG8_LDA(At, 1, 1); PG8_STAGE(PG8_SA(1, 0), a3, voffA);
            PG8_BAR; PG8_WAIT_L(0); PG8_MMA(1, 0, At, B0); PG8_BAR; PG8_SCHED;
            PG8_STAGE(PG8_SB(1, 1), b3 + hstep, voffB);
            PG8_WAIT_V(6); PG8_BAR; PG8_MMA(1, 1, At, B1); PG8_BAR;
            }
        }
        if constexpr (ALIGN_EPI) { if (wr == 0) PG8_BAR; }
        if constexpr (F8) asm volatile("s_nop 15\n\ts_nop 15" ::: "memory");
        if constexpr (!Epi::AFTER_DRAIN) { E(acc, cur, wr, wc, fr, fq); S.done(cur); }
        if (!has_next) break;
#pragma unroll
        for (int a = 0; a < 2; ++a)
#pragma unroll
            for (int b = 0; b < 2; ++b)
#pragma unroll
                for (int m = 0; m < 4; ++m)
#pragma unroll
                    for (int n = 0; n < 2; ++n) acc[a][b][m][n] = (f32x4){0.f, 0.f, 0.f, 0.f};
        cur = nxt; cA = nA; cB = nB; ++ui; nt = cur.nt;
        if constexpr (ALIGN_EPI) { if (wr == 1) PG8_BAR; }
    }
    PG8_WAIT_V(0);
    if constexpr (!ALIGN_EPI) { if (wr == 0) PG8_BAR; }
    PG8_BAR;
    if constexpr (Epi::AFTER_DRAIN) { E.fused(acc, cur, wr, wc, fr, fq, lds, wid, lane); S.done(cur); }
#undef PG8_SA
#undef PG8_SB
#undef PG8_STAGE
#undef PG8_LDA
#undef PG8_LDB
#undef PG8_MMA
#undef PG8_WAIT_V
#undef PG8_WAIT_L
#undef PG8_BAR
#undef PG8_SCHED
}
}

#define GAS __attribute__((address_space(1)))
#define LAS __attribute__((address_space(3)))
typedef unsigned short bf16;
typedef unsigned v4u __attribute__((ext_vector_type(4)));
typedef float f32x4 __attribute__((ext_vector_type(4)));
typedef short bf16x8 __attribute__((ext_vector_type(8)));
typedef GAS unsigned gu32;
typedef GAS unsigned long long gu64;
#define RLX_AGENT __ATOMIC_RELAXED, __HIP_MEMORY_SCOPE_AGENT
#define LDS_WAIT() asm volatile("s_waitcnt lgkmcnt(0)" ::: "memory")
#define VM_WAIT() asm volatile("s_waitcnt vmcnt(0)" ::: "memory")
__device__ __forceinline__ unsigned long long rt() { return __builtin_amdgcn_s_memrealtime(); }
__device__ __forceinline__ unsigned f2bf(float f) { unsigned u = __builtin_bit_cast(unsigned, f); return (u + 0x7fffu + ((u >> 16) & 1u)) >> 16; }
__device__ __forceinline__ unsigned pk2(float lo, float hi) { unsigned r; asm volatile("v_cvt_pk_bf16_f32 %0, %1, %2" : "=v"(r) : "v"(lo), "v"(hi)); return r; }

#define XB_TMO      128
#define XB_XCNT(j)  (256  + 64 * (j))
#define XB_XSUB(j)  (1280 + 64 * (j))
#define XB_XGEN(j)  (2304 + 64 * (j))
#define XB_TOP      3328
#define XB_TOPGEN   3392
#define XCD_BAR_WORDS 3456
#define XB_SPIN_CAP (1u << 18)

__device__ __forceinline__ unsigned xb_ld(unsigned* p)              { return __hip_atomic_load(p, __ATOMIC_RELAXED, __HIP_MEMORY_SCOPE_AGENT); }
__device__ __forceinline__ unsigned xb_add(unsigned* p, unsigned v) { return __hip_atomic_fetch_add(p, v, __ATOMIC_RELAXED, __HIP_MEMORY_SCOPE_AGENT); }
__device__ __forceinline__ unsigned xb_xcc_id() { return (unsigned)__builtin_amdgcn_s_getreg((3 << 11) | 20) & 0xFu; }
#define XB_SPIN(cond, bar) do { unsigned _sp = 0; while (cond) { __builtin_amdgcn_s_sleep(1); \
    if ((++_sp & 255u) == 0u) { if (xb_ld(&(bar)[XB_TMO])) break; if (_sp > XB_SPIN_CAP) { atomicAdd(&(bar)[XB_TMO], 1u); break; } } } } while (0)

struct XcdBarrier {
    unsigned* bar; unsigned x;
    volatile LAS unsigned* st;
};

__device__ __forceinline__ XcdBarrier xcd_barrier_post(unsigned* bar, volatile LAS unsigned* st) {
    XcdBarrier b; b.bar = bar; b.x = xb_xcc_id(); b.st = st;
    if (threadIdx.x == 0) (void)xb_add(&bar[XB_XCNT(b.x)], 1u);
    return b;
}
__device__ __forceinline__ void xcd_barrier_complete(unsigned* bar, unsigned x, unsigned& nloc, unsigned& nx) {
    const unsigned G = gridDim.x * gridDim.y * gridDim.z;
    unsigned sum, cnt, mine, sp = 0u;
    for (;;) {
        sum = 0u; cnt = 0u; mine = 0u;
#pragma unroll
        for (unsigned j = 0; j < 16; ++j) { const unsigned c = xb_ld(&bar[XB_XCNT(j)]); sum += c; cnt += (c > 0u) ? 1u : 0u; mine = (j == x) ? c : mine; }
        if (sum == G) break;
        __builtin_amdgcn_s_sleep(1);
        if ((++sp & 255u) == 0u) { if (xb_ld(&bar[XB_TMO])) break; if (sp > XB_SPIN_CAP) { atomicAdd(&bar[XB_TMO], 1u); break; } }
    }
    nloc = mine > 0u ? mine : 1u; nx = cnt > 0u ? cnt : 1u;
}

__device__ __forceinline__ void xcd_barrier(const XcdBarrier& b) {
    asm volatile("s_waitcnt vmcnt(0)" ::: "memory");
    __syncthreads();
    if (threadIdx.x == 0) {
        unsigned* bar = b.bar;
        __builtin_amdgcn_s_waitcnt(0);
        unsigned nloc = b.st[0], nx = b.st[1];
        if (nloc == 0u) { xcd_barrier_complete(bar, b.x, nloc, nx); b.st[0] = nloc; b.st[1] = nx; }
        const unsigned old = xb_add(&bar[XB_XSUB(b.x)], 1u);
        const unsigned gen = old / nloc;
        if (old + 1u == (gen + 1u) * nloc) {
            __builtin_amdgcn_fence(__ATOMIC_RELEASE, "agent");
            asm volatile("s_waitcnt vmcnt(0)" ::: "memory");
            const unsigned og = xb_add(&bar[XB_TOP], 1u);
            const unsigned tg = og / nx;
            if (og + 1u == (tg + 1u) * nx) xb_add(&bar[XB_TOPGEN], 1u);
            else XB_SPIN(xb_ld(&bar[XB_TOPGEN]) == tg, bar);
            __builtin_amdgcn_fence(__ATOMIC_ACQUIRE, "agent");
            xb_add(&bar[XB_XGEN(b.x)], 1u);
            asm volatile("s_waitcnt vmcnt(0)" ::: "memory");
        } else {
            XB_SPIN(xb_ld(&bar[XB_XGEN(b.x)]) == gen, bar);
            __builtin_amdgcn_fence(__ATOMIC_ACQUIRE, "agent");
            asm volatile("s_waitcnt vmcnt(0)" ::: "memory");
        }
    }
    __syncthreads();
}

constexpr int NWAVES = 8;
constexpr int DM = 4096, TOKP = 8192, TOKS = 256, MTOK = TOKP + TOKS, INW = 25600, FFH = 16384, PLED = 256;
constexpr int AW = 1024, HGW = 2048;
constexpr size_t al256(size_t x) { return (x + 255) & ~(size_t)255; }
constexpr size_t WS_CTL = 0, CTL_ZERO_BYTES = 128u << 10;
constexpr size_t WS_WIN   = CTL_ZERO_BYTES;
constexpr size_t WS_WFFU  = WS_WIN  + (size_t)INW * DM * 2;
constexpr size_t WS_WFFD  = WS_WFFU + (size_t)FFH * DM * 2;
constexpr size_t WS_WOUT  = WS_WFFD + (size_t)DM * FFH * 2;
constexpr size_t WS_WPG   = WS_WOUT + (size_t)DM * DM * 2;
constexpr size_t WS_WUPA  = WS_WPG  + (size_t)DM * DM * 2;
constexpr size_t WS_WUPH  = WS_WUPA + (size_t)DM * AW * 2;
constexpr size_t WS_WPLE  = WS_WUPH + (size_t)DM * HGW * 2;
constexpr size_t WS_XB    = WS_WPLE + (size_t)DM * PLED * 2;
constexpr size_t WS_R0    = WS_XB   + (size_t)MTOK * DM * 2;
constexpr size_t WS_PB    = al256(WS_R0 + (size_t)MTOK * 4);
constexpr size_t WS_Q     = WS_PB   + (size_t)MTOK * PLED * 2;
constexpr size_t WS_K     = WS_Q    + (size_t)MTOK * 3072 * 2;
constexpr size_t WS_V     = WS_K    + (size_t)MTOK * 3072 * 2;
constexpr size_t WS_HQ    = WS_V    + (size_t)MTOK * 3072 * 2;
constexpr size_t WS_KK    = WS_HQ   + (size_t)MTOK * HGW * 2;
constexpr size_t WS_HI    = WS_KK   + (size_t)MTOK * HGW * 2;
constexpr size_t WS_OG    = WS_HI   + (size_t)MTOK * HGW * 2;
constexpr size_t WS_LG    = WS_OG   + (size_t)MTOK * HGW * 2;
constexpr size_t WS_SA    = WS_LG   + (size_t)MTOK * HGW * 4;
constexpr size_t WS_SB    = WS_SA   + (size_t)MTOK * DM * 2;
constexpr size_t WS_PP    = WS_SB   + (size_t)MTOK * DM * 2;
constexpr size_t WS_OATT  = WS_PP   + (size_t)MTOK * DM * 2;
constexpr size_t WS_OHG   = WS_OATT + (size_t)MTOK * AW * 2;
constexpr size_t WS_P1B   = WS_OHG  + (size_t)MTOK * HGW * 2;
constexpr size_t WS_MRG   = WS_P1B  + (size_t)MTOK * DM * 2;
constexpr size_t WS_X1B   = WS_MRG  + (size_t)MTOK * DM * 2;
constexpr size_t WS_X2B   = WS_X1B  + (size_t)MTOK * DM * 2;
constexpr size_t WS_U     = WS_X2B  + (size_t)MTOK * DM * 2;
constexpr size_t WS_OGA   = WS_U    + (size_t)MTOK * FFH * 2;
constexpr size_t WS_LSE   = WS_OGA  + (size_t)3 * MTOK * AW * 2;
constexpr size_t WS_SST   = WS_LSE  + (size_t)3 * MTOK * 8 * 4;
constexpr size_t WS_DSC   = WS_SST  + (size_t)16 * 32 * 16384 * 4;
constexpr size_t WS_PART  = WS_DSC  + (size_t)16 * 32 * 128 * 4;
constexpr size_t WS_X2F8  = WS_PART + (size_t)16 * 256 * 4096 * 4;
constexpr size_t WS_XF8   = WS_X2F8 + (size_t)MTOK * DM;
constexpr size_t WS_END   = WS_XF8  + (size_t)MTOK * DM;
constexpr int IN16_LO = 3072, IN16_N = 12288, IN8_Q = 3072, IN8_G = 10240;
constexpr size_t WS_WIN8  = WS_WIN + (size_t)IN16_N * DM * 2;
static_assert(WS_WIN8 + (size_t)(IN8_Q + IN8_G) * DM <= WS_WFFU, "w_in copies");
static_assert(WS_END <= 2147483648ull, "workspace");
constexpr int CW_BAR = 4096;
constexpr int CW_FIN = 8192;
constexpr int CW_SSQ = 16384;
static_assert((CW_SSQ + MTOK) * 4 <= (int)CTL_ZERO_BYTES && CW_BAR + XCD_BAR_WORDS <= CW_FIN && CW_FIN + 4 * 64 <= CW_SSQ, "CTL map");
constexpr int RING_OFF = 0, RING_BYTES = 131072;
constexpr int TAB_OFF = RING_BYTES;
constexpr int MISC_OFF = 147456;
constexpr int PTAB_OFF = MISC_OFF + 256;
constexpr int LDS_BYTES = 155648;
static_assert(MISC_OFF + 128 <= LDS_BYTES, "LDS map");

struct Args {
    const float* in[22]; float* out; unsigned char* ws; int ph_lo, ph_hi;
};
static_assert(sizeof(Args) == 22 * 8 + 8 + 8 + 8, "no padding");

__device__ __forceinline__ float wave_sum(float v) {
#pragma unroll
    for (int o = 1; o < 64; o <<= 1) v += __shfl_xor(v, o);
    return v;
}
__device__ __forceinline__ float bf2f(unsigned short b) { return __uint_as_float(((unsigned)b) << 16); }

struct P0Item { const float* src; const float* gain; unsigned char* dst; int N, K, f8; };
__device__ __forceinline__ void p0_item_load(const P0Item& d, f32x4 (&v)[16], int lane) {
    const int lr = lane >> 4, lc = lane & 15;
#pragma unroll
    for (int i = 0; i < 16; ++i) v[i] = *(const GAS f32x4*)(d.src + (size_t)(4 * i + lr) * d.N + 4 * lc);
}
__device__ __forceinline__ void p0_item_store(const P0Item& d, const f32x4 (&v)[16], LAS float* scr, int lane) {
    const int lr = lane >> 4, lc = lane & 15;
    const int c = lane & 7, r = lane >> 3;
    f32x4 g0 = {1.f, 1.f, 1.f, 1.f}, g1 = g0;
    if (d.gain) { g0 = *(const GAS f32x4*)(d.gain + 8 * c); g1 = *(const GAS f32x4*)(d.gain + 8 * c + 4); }
    if (d.f8) { g0 = g0 * 64.f; g1 = g1 * 64.f; }
#pragma unroll
    for (int i = 0; i < 16; ++i) { LAS float* p = scr + (4 * i + lr) * 65 + 4 * lc; p[0] = v[i].x; p[1] = v[i].y; p[2] = v[i].z; p[3] = v[i].w; }
    LDS_WAIT(); asm volatile("" ::: "memory");
    if (d.f8) {
#pragma unroll
        for (int j = 0; j < 8; ++j) { const int n = 8 * j + r; const LAS float* s = scr + (8 * c) * 65 + n;
            int w0 = __builtin_amdgcn_cvt_pk_fp8_f32(s[0 * 65] * g0[0], s[1 * 65] * g0[1], 0, false); w0 = __builtin_amdgcn_cvt_pk_fp8_f32(s[2 * 65] * g0[2], s[3 * 65] * g0[3], w0, true);
            int w1 = __builtin_amdgcn_cvt_pk_fp8_f32(s[4 * 65] * g1[0], s[5 * 65] * g1[1], 0, false); w1 = __builtin_amdgcn_cvt_pk_fp8_f32(s[6 * 65] * g1[2], s[7 * 65] * g1[3], w1, true);
            typedef int i32x2_t __attribute__((ext_vector_type(2)));
            *(GAS i32x2_t*)(d.dst + (size_t)n * d.K + 8 * c) = (i32x2_t){w0, w1}; }
    } else {
#pragma unroll
        for (int j = 0; j < 8; ++j) { const int n = 8 * j + r; const LAS float* s = scr + (8 * c) * 65 + n;
            v4u o; o.x = pk2(s[0 * 65] * g0[0], s[1 * 65] * g0[1]); o.y = pk2(s[2 * 65] * g0[2], s[3 * 65] * g0[3]); o.z = pk2(s[4 * 65] * g1[0], s[5 * 65] * g1[1]); o.w = pk2(s[6 * 65] * g1[2], s[7 * 65] * g1[3]);
            *(GAS v4u*)(d.dst + ((size_t)n * d.K + 8 * c) * 2) = o; }
    }
    LDS_WAIT(); asm volatile("" ::: "memory");
}

struct Frame {
    LAS unsigned char* lds;
    int tid, lane, wave, G;
    float* out; unsigned char* ws;
};
enum { I_XP = 0, I_XS, I_C128, I_C512, I_C2048, I_ST, I_PP, I_PS, I_GMIX, I_WIN, I_GQ, I_GK, I_LB, I_GHG, I_WUPA, I_WUPH, I_WOUT, I_GFFN, I_WFFU, I_WFFD, I_WPLE, I_WPG };

constexpr int P0_I_IN = (DM / 64) * (IN16_N / 64), P0_I_IN8Q = (DM / 64) * (IN8_Q / 64), P0_I_IN8G = (DM / 64) * (IN8_G / 64), P0_I_IN8 = P0_I_IN8Q + P0_I_IN8G, P0_I_PL = (PLED / 64) * (DM / 64), P0_I_FU = (DM / 64) * (FFH / 64), P0_I_FD = (FFH / 64) * (DM / 64),
              P0_I_SQ = (DM / 64) * (DM / 64), P0_I_UA = (AW / 64) * (DM / 64), P0_I_UH = (HGW / 64) * (DM / 64);
constexpr int P0_NITEMS = P0_I_IN + P0_I_IN8 + P0_I_PL + P0_I_FU + P0_I_FD + 2 * P0_I_SQ + P0_I_UA + P0_I_UH;
#ifndef P0_DEF1_V
#define P0_DEF1_V 24
#endif
#ifndef P0_DEF1B_V
#define P0_DEF1B_V 120
#endif
constexpr int P0_SL_LO = 48, P0_SL_HI = 228;
constexpr int P0_DEF1 = P0_DEF1_V, P0_DEF1B = P0_DEF1B_V, P0_NDEF1 = (P0_SL_HI - P0_SL_LO) * P0_DEF1 + (256 - P0_SL_HI) * P0_DEF1B;
constexpr int P0_DEF2 = 80, P0_NDEF2 = (192 + 128) * P0_DEF2, P0_NDEF = P0_NDEF1 + P0_NDEF2;
#ifndef USE_DEF3
#define P0_DEF3_V 0
#endif
#ifndef P0_DEF3_V
#define P0_DEF3_V 42
#endif
constexpr int P0_DEF3 = P0_DEF3_V, P0_NDEF3 = 256 * P0_DEF3;
static_assert(P0_NITEMS - P0_NDEF - P0_NDEF3 >= P0_I_IN + P0_I_IN8 + P0_I_PL, "copies the input-projection phase itself reads must not be deferred");
static_assert(P0_NITEMS - P0_NDEF2 >= P0_I_IN + P0_I_IN8 + P0_I_PL + P0_I_UA + P0_I_UH, "copies the up-projection phase reads must not be deferred into it");
__device__ __forceinline__ void p0_ptab(Frame& F, const Args& A) {
    LAS unsigned long long* ptab = (LAS unsigned long long*)(F.lds + PTAB_OFF);
    if (F.tid == 0) {
        ptab[0] = (unsigned long long)A.in[I_WIN];  ptab[1] = (unsigned long long)A.in[I_GMIX];
        ptab[2] = (unsigned long long)A.in[I_WIN];  ptab[3] = (unsigned long long)A.in[I_GMIX];
        ptab[4] = (unsigned long long)A.in[I_WIN];  ptab[5] = (unsigned long long)A.in[I_GMIX];
        ptab[6] = (unsigned long long)A.in[I_WPLE]; ptab[7] = 0ull;
        ptab[8] = (unsigned long long)A.in[I_WUPA]; ptab[9] = 0ull;
        ptab[10] = (unsigned long long)A.in[I_WUPH]; ptab[11] = 0ull;
        ptab[12] = (unsigned long long)A.in[I_WOUT]; ptab[13] = 0ull;
        ptab[14] = (unsigned long long)A.in[I_WPG]; ptab[15] = 0ull;
        ptab[16] = (unsigned long long)A.in[I_WFFU]; ptab[17] = (unsigned long long)A.in[I_GFFN];
        ptab[18] = (unsigned long long)A.in[I_WFFD]; ptab[19] = 0ull;
    }
    __syncthreads();
}
__device__ __forceinline__ void p0_items_run(Frame& F, const int first, const int last, const int w0, const int stride) {
    LAS float* scr = (LAS float*)(F.lds + RING_OFF + F.wave * 16640);
    unsigned char* wsb = F.ws;
    LAS unsigned long long* ptab = (LAS unsigned long long*)(F.lds + PTAB_OFF);
#define P0_DESC(IT, D) do { int r_ = (IT); int mi_; size_t o_; int K_, Nc_, N_, f8_ = 0, cb_ = 0; \
        if (r_ < P0_I_IN) { mi_ = 0; o_ = WS_WIN; K_ = DM; Nc_ = IN16_N; N_ = INW; cb_ = IN16_LO; } \
        else if ((r_ -= P0_I_IN) < P0_I_IN8Q) { mi_ = 1; o_ = WS_WIN8; K_ = DM; Nc_ = IN8_Q; N_ = INW; f8_ = 1; cb_ = 0; } \
        else if ((r_ -= P0_I_IN8Q) < P0_I_IN8G) { mi_ = 2; o_ = WS_WIN8 + (size_t)IN8_Q * DM; K_ = DM; Nc_ = IN8_G; N_ = INW; f8_ = 1; cb_ = 15360; } \
        else if ((r_ -= P0_I_IN8G) < P0_I_PL) { mi_ = 3; o_ = WS_WPLE; K_ = PLED; Nc_ = DM; N_ = DM; } \
        else if ((r_ -= P0_I_PL) < P0_I_UA) { mi_ = 4; o_ = WS_WUPA; K_ = AW; Nc_ = DM; N_ = DM; } \
        else if ((r_ -= P0_I_UA) < P0_I_UH) { mi_ = 5; o_ = WS_WUPH; K_ = HGW; Nc_ = DM; N_ = DM; } \
        else if ((r_ -= P0_I_UH) < P0_I_SQ) { mi_ = 6; o_ = WS_WOUT; K_ = DM; Nc_ = DM; N_ = DM; } \
        else if ((r_ -= P0_I_SQ) < P0_I_SQ) { mi_ = 7; o_ = WS_WPG; K_ = DM; Nc_ = DM; N_ = DM; f8_ = 1; } \
        else if ((r_ -= P0_I_SQ) < P0_I_FU) { mi_ = 8; o_ = WS_WFFU; K_ = DM; Nc_ = FFH; N_ = FFH; } \
        else { r_ -= P0_I_FU; mi_ = 9; o_ = WS_WFFD; K_ = FFH; Nc_ = DM; N_ = DM; } \
        const float* W_ = (const float*)ptab[2 * mi_]; const float* g_ = (const float*)ptab[2 * mi_ + 1]; \
        const int nblk_ = Nc_ / 64, kb_ = r_ / nblk_, nb_ = r_ - kb_ * nblk_; \
        (D).src = W_ + (size_t)(64 * kb_) * N_ + cb_ + 64 * nb_; (D).gain = g_ ? g_ + 64 * kb_ : nullptr; (D).N = N_; (D).K = K_; (D).f8 = f8_; \
        (D).dst = wsb + o_ + ((size_t)(64 * nb_) * K_ + 64 * kb_) * (f8_ ? 1 : 2); } while (0)
    {
        P0Item d0, d1; f32x4 va[16], vb[16];
        int it = first + w0;
        if (it < last) { P0_DESC(it, d0); p0_item_load(d0, va, F.lane); }
        while (it < last) {
            int it2 = it + stride;
            if (it2 < last) { P0_DESC(it2, d1); p0_item_load(d1, vb, F.lane); }
            p0_item_store(d0, va, scr, F.lane);
            it = it2; if (it >= last) break;
            it2 = it + stride;
            if (it2 < last) { P0_DESC(it2, d0); p0_item_load(d0, va, F.lane); }
            p0_item_store(d1, vb, scr, F.lane);
            it = it2;
        }
    }
#undef P0_DESC
}
__device__ __forceinline__ void p0_items(Frame& F, const Args& A, const int first, const int last, const int w0, const int stride) { p0_ptab(F, A); p0_items_run(F, first, last, w0, stride); }
__device__ __forceinline__ void p0_prologue(Frame& F, const Args& A) {
    const int gw = blockIdx.x * NWAVES + F.wave, NGW = F.G * NWAVES;
    p0_items(F, A, 0, P0_NITEMS - (F.G == 256 ? P0_NDEF + P0_NDEF3 : 0), gw, NGW);
    for (int m = gw; m < MTOK; m += NGW) {
        const float* xrow = m < TOKP ? A.in[I_XP] + (size_t)m * DM : A.in[I_XS] + (size_t)(m - TOKP) * DM;
        const GAS f32x4* xr = (const GAS f32x4*)xrow + F.lane;
        GAS unsigned long long* o8 = (GAS unsigned long long*)((bf16*)(F.ws + WS_XB) + (size_t)m * DM) + F.lane;
        float s = 0.f;
        f32x4 xv[16];
#pragma unroll
        for (int j = 0; j < 16; ++j) xv[j] = xr[64 * j];
#pragma unroll
        for (int j = 0; j < 16; ++j) { const f32x4 v = xv[j]; s += (v.x * v.x + v.y * v.y) + (v.z * v.z + v.w * v.w);
            o8[64 * j] = (unsigned long long)pk2(v.x, v.y) | ((unsigned long long)pk2(v.z, v.w) << 32);
            { int w8 = __builtin_amdgcn_cvt_pk_fp8_f32(v.x, v.y, 0, false); w8 = __builtin_amdgcn_cvt_pk_fp8_f32(v.z, v.w, w8, true); ((GAS int*)(F.ws + WS_XF8 + (size_t)m * DM))[F.lane + 64 * j] = w8; } }
        s = wave_sum(s);
        if (F.lane == 0) ((float*)(F.ws + WS_R0))[m] = rsqrtf(s * (1.0f / DM) + 1e-6f);
        const float* prow = m < TOKP ? A.in[I_PP] + (size_t)m * PLED : A.in[I_PS] + (size_t)(m - TOKP) * PLED;
        const f32x4 pv = ((const GAS f32x4*)prow)[F.lane];
        ((GAS unsigned long long*)((bf16*)(F.ws + WS_PB) + (size_t)m * PLED))[F.lane] = (unsigned long long)pk2(pv.x, pv.y) | ((unsigned long long)pk2(pv.z, pv.w) << 32);
    }
}

__device__ __forceinline__ void attn_naive_phase(Frame& F, const Args& A) {
    const bf16* Q = (const bf16*)(F.ws + WS_Q); const bf16* K = (const bf16*)(F.ws + WS_K); const bf16* V = (const bf16*)(F.ws + WS_V);
    bf16* O = (bf16*)(F.ws + WS_OATT);
    const int gw = blockIdx.x * NWAVES + F.wave, NGW = F.G * NWAVES, lane = F.lane;
    for (int it = gw; it < MTOK * 8; it += NGW) {
        const int m = it >> 3, h = it & 7;
        float mx = -1e30f, sum = 0.f, o0 = 0.f, o1 = 0.f;
        for (int g = 0; g < 3; ++g) {
            const int dil = 1 << (2 * g), L = 128 << (2 * g);
            const float slope = exp2f(-8.0f * (float)(g * 8 + h + 1) / 24.0f) * (float)dil;
            const int co = g * 1024 + h * 128 + 2 * lane;
            const unsigned qw = *(const unsigned*)(Q + (size_t)m * 3072 + co);
            const float q0 = __uint_as_float(qw << 16) * 0.08838834764831845f, q1 = __uint_as_float(qw & 0xffff0000u) * 0.08838834764831845f;
            const float* cache = A.in[I_C128 + g];
            const int b = (m - TOKP) >> 3, t = (m - TOKP) & 7;
            for (int j = 0; j <= 128; ++j) {
                float k0, k1, v0, v1;
                if (m < TOKP) {
                    const int pos = m - dil * j; if (pos < 0) break;
                    const unsigned kw = *(const unsigned*)(K + (size_t)pos * 3072 + co), vw = *(const unsigned*)(V + (size_t)pos * 3072 + co);
                    k0 = __uint_as_float(kw << 16); k1 = __uint_as_float(kw & 0xffff0000u); v0 = __uint_as_float(vw << 16); v1 = __uint_as_float(vw & 0xffff0000u);
                } else {
                    const int idx = L + t - dil * j; if (idx < 0) break;
                    if (idx >= L) {
                        const size_t r = (size_t)(TOKP + b * 8 + (idx - L));
                        const unsigned kw = *(const unsigned*)(K + r * 3072 + co), vw = *(const unsigned*)(V + r * 3072 + co);
                        k0 = __uint_as_float(kw << 16); k1 = __uint_as_float(kw & 0xffff0000u); v0 = __uint_as_float(vw << 16); v1 = __uint_as_float(vw & 0xffff0000u);
                    } else {
                        const float* cr = cache + (((size_t)b * L + idx) * 2) * 1024 + h * 128 + 2 * lane;
                        k0 = cr[0]; k1 = cr[1]; v0 = cr[1024]; v1 = cr[1025];
                    }
                }
                float s = wave_sum(q0 * k0 + q1 * k1) - slope * (float)j;
                const float mn = fmaxf(mx, s), al = __expf(mx - mn), p = __expf(s - mn);
                sum = sum * al + p; o0 = o0 * al + p * v0; o1 = o1 * al + p * v1; mx = mn;
            }
        }
        const float inv = 1.0f / sum;
        *(unsigned*)(O + (size_t)m * 1024 + h * 128 + 2 * lane) = pk2(o0 * inv, o1 * inv);
    }
}

typedef short s16x4 __attribute__((ext_vector_type(4)));
constexpr int ATT_KS = 272, ATT_VS = 288;
constexpr int ATT_K_OFF = 0, ATT_V_OFF = 256 * ATT_KS;
static_assert(ATT_V_OFF + 256 * ATT_VS <= MISC_OFF, "attention LDS map");
template <int OFF> __device__ __forceinline__ s16x4 tr_read(unsigned vb) {
    s16x4 r; asm volatile("ds_read_b64_tr_b16 %0, %1 offset:%2" : "=&v"(r) : "v"(vb), "i"(OFF) : "memory"); return r;
}
#define MFMA16(a, b, c) __builtin_amdgcn_mfma_f32_16x16x32_bf16((a), (b), (c), 0, 0, 0)
template <int DT> __device__ __forceinline__ void att_pv_one(f32x4& od, unsigned vb, const bf16x8 (&P)[5]) {
    constexpr int TS = 16 * ATT_VS;
    const s16x4 a0 = tr_read<0 * TS + DT * 32>(vb), a1 = tr_read<1 * TS + DT * 32>(vb), a2 = tr_read<2 * TS + DT * 32>(vb), a3 = tr_read<3 * TS + DT * 32>(vb), a4 = tr_read<4 * TS + DT * 32>(vb);
    const s16x4 a5 = tr_read<5 * TS + DT * 32>(vb), a6 = tr_read<6 * TS + DT * 32>(vb), a7 = tr_read<7 * TS + DT * 32>(vb), a8 = tr_read<8 * TS + DT * 32>(vb), a9 = tr_read<9 * TS + DT * 32>(vb);
    asm volatile("s_waitcnt lgkmcnt(0)" ::: "memory"); __builtin_amdgcn_sched_barrier(0);
#define PK8(L, H) (bf16x8){L[0], L[1], L[2], L[3], H[0], H[1], H[2], H[3]}
    od = MFMA16(PK8(a0, a1), P[0], od); od = MFMA16(PK8(a2, a3), P[1], od); od = MFMA16(PK8(a4, a5), P[2], od); od = MFMA16(PK8(a6, a7), P[3], od); od = MFMA16(PK8(a8, a9), P[4], od);
#undef PK8
}
__device__ __forceinline__ unsigned cvtpk(float lo, float hi) { unsigned r; asm volatile("v_cvt_pk_bf16_f32 %0, %1, %2" : "=v"(r) : "v"(lo), "v"(hi)); return r; }

__device__ __forceinline__ void attn_prompt_phase(Frame& F, const Args& A) {
    const bf16* Q = (const bf16*)(F.ws + WS_Q); const bf16* K = (const bf16*)(F.ws + WS_K); const bf16* V = (const bf16*)(F.ws + WS_V);
    bf16* OGA = (bf16*)(F.ws + WS_OGA); float* LSE = (float*)(F.ws + WS_LSE);
    const int tid = F.tid, lane = F.lane, w = F.wave, l15 = lane & 15, kq = lane >> 4;
    const unsigned ldsb = (unsigned)(size_t)F.lds;
#define ATT_BAR() do { asm volatile("s_waitcnt lgkmcnt(0)" ::: "memory"); __builtin_amdgcn_s_barrier(); asm volatile("" ::: "memory"); } while (0)
    v4u kreg[8], vreg[8];
#define ATT_PREFETCH(U) do { const int g_ = (U) >> 9, rem_ = (U) & 511, h_ = rem_ >> 6, c_ = rem_ & 63, dil_ = 1 << (2 * g_), sh_ = 6 - 2 * g_, z_ = c_ >> sh_, n_ = c_ & ((1 << sh_) - 1); \
        const size_t colb_ = (size_t)g_ * 1024 + h_ * 128; \
        _Pragma("unroll") for (int e = 0; e < 8; ++e) { const int j_ = (tid >> 4) + 32 * e, u_ = 128 * (n_ - 1) + j_; \
            kreg[e] = (v4u){0u, 0u, 0u, 0u}; vreg[e] = (v4u){0u, 0u, 0u, 0u}; \
            if (u_ >= 0) { const size_t off_ = (size_t)(u_ * dil_ + z_) * 3072 + colb_ + (tid & 15) * 8; kreg[e] = *(const GAS v4u*)(K + off_); vreg[e] = *(const GAS v4u*)(V + off_); } } } while (0)
    if ((int)blockIdx.x < 1536) ATT_PREFETCH((int)blockIdx.x);
    for (int unit = blockIdx.x; unit < 1536; unit += F.G) {
        const int g = unit >> 9, rem = unit & 511, h = rem >> 6, c = rem & 63;
        const int dil = 1 << (2 * g), sh = 6 - 2 * g, z = c >> sh, n = c & ((1 << sh) - 1);
        const size_t colb = (size_t)g * 1024 + h * 128;
        ATT_BAR();
#pragma unroll
        for (int e = 0; e < 8; ++e) { const int j = (tid >> 4) + 32 * e, ch = tid & 15;
            *(LAS v4u*)(F.lds + ATT_K_OFF + j * ATT_KS + ch * 16) = kreg[e]; *(LAS v4u*)(F.lds + ATT_V_OFF + j * ATT_VS + ch * 16) = vreg[e]; }
        const int tokq = (128 * n + 16 * w + l15) * dil + z;
        bf16x8 qf[4];
#pragma unroll
        for (int ks = 0; ks < 4; ++ks) qf[ks] = *(const GAS bf16x8*)(Q + (size_t)tokq * 3072 + colb + 32 * ks + 8 * kq);
        if (unit + F.G < 1536) ATT_PREFETCH(unit + F.G);
        ATT_BAR();
        const int ts = w & ~1;
        f32x4 T[10];
#pragma unroll
        for (int ti = 0; ti < 10; ++ti) {
            T[ti] = (f32x4){0.f, 0.f, 0.f, 0.f};
#pragma unroll
            for (int ks = 0; ks < 4; ++ks) {
                const bf16x8 a = *(const LAS bf16x8*)(F.lds + ATT_K_OFF + (16 * (ts + ti) + l15) * ATT_KS + (32 * ks + 8 * kq) * 2);
                T[ti] = MFMA16(a, qf[ks], T[ti]);
            }
        }
        const float c1 = 0.08838834764831845f * 1.4426950408889634f;
        const float cs = exp2f(-8.0f * (float)(g * 8 + h + 1) / 24.0f) * (float)dil * 1.4426950408889634f;
        const int i = 16 * w + l15;
        float mx = -__builtin_inff();
#pragma unroll
        for (int ti = 0; ti < 10; ++ti)
#pragma unroll
            for (int r = 0; r < 4; ++r) {
                const int j = 16 * (ts + ti) + 4 * kq + r, delta = 128 + i - j;
                const bool valid = ((unsigned)delta <= 128u) && (n > 0 || j >= 128);
                const float v = valid ? T[ti][r] * c1 - cs * (float)delta : -__builtin_inff();
                T[ti][r] = v; mx = fmaxf(mx, v);
            }
        mx = fmaxf(mx, __shfl_xor(mx, 16)); mx = fmaxf(mx, __shfl_xor(mx, 32));
        float sum = 0.f;
#pragma unroll
        for (int ti = 0; ti < 10; ++ti)
#pragma unroll
            for (int r = 0; r < 4; ++r) { const float p = __builtin_amdgcn_exp2f(T[ti][r] - mx); T[ti][r] = p; sum += p; }
        sum += __shfl_xor(sum, 16); sum += __shfl_xor(sum, 32);
        bf16x8 P[5];
#pragma unroll
        for (int p = 0; p < 5; ++p) { v4u wv; wv.x = cvtpk(T[2 * p][0], T[2 * p][1]); wv.y = cvtpk(T[2 * p][2], T[2 * p][3]); wv.z = cvtpk(T[2 * p + 1][0], T[2 * p + 1][1]); wv.w = cvtpk(T[2 * p + 1][2], T[2 * p + 1][3]);
            P[p] = __builtin_bit_cast(bf16x8, wv); }
        const unsigned vb = ldsb + ATT_V_OFF + (16 * ts + 4 * kq + (l15 >> 2)) * ATT_VS + (l15 & 3) * 8;
        f32x4 O[8];
#pragma unroll
        for (int dt = 0; dt < 8; ++dt) O[dt] = (f32x4){0.f, 0.f, 0.f, 0.f};
        att_pv_one<0>(O[0], vb, P); att_pv_one<1>(O[1], vb, P); att_pv_one<2>(O[2], vb, P); att_pv_one<3>(O[3], vb, P);
        att_pv_one<4>(O[4], vb, P); att_pv_one<5>(O[5], vb, P); att_pv_one<6>(O[6], vb, P); att_pv_one<7>(O[7], vb, P);
        const float inv = 1.0f / sum;
        bf16* orow = OGA + ((size_t)g * MTOK + tokq) * 1024 + h * 128 + 4 * kq;
#pragma unroll
        for (int dt = 0; dt < 8; ++dt) {
            const unsigned long long pk = (unsigned long long)cvtpk(O[dt][0] * inv, O[dt][1] * inv) | ((unsigned long long)cvtpk(O[dt][2] * inv, O[dt][3] * inv) << 32);
            *(GAS unsigned long long*)(orow + 16 * dt) = pk;
        }
        if (kq == 0) LSE[((size_t)g * MTOK + tokq) * 8 + h] = mx + __log2f(sum);
    }
}

__device__ __forceinline__ void attn_sample_phase(Frame& F, const Args& A) {
    const bf16* Q = (const bf16*)(F.ws + WS_Q);
    bf16* OGA = (bf16*)(F.ws + WS_OGA); float* LSE = (float*)(F.ws + WS_LSE);
    LAS float* qs = (LAS float*)(F.lds + F.wave * 1280);
    LAS float* ps = qs + 128;
    const int gw = blockIdx.x * NWAVES + F.wave, NGW = F.G * NWAVES, lane = F.lane;
    for (int it = gw; it < 6144; it += NGW) {
        const int g = it >> 11, r = it & 2047, t = r & 7, h = (r >> 3) & 7, b = r >> 6, ms = b * 8 + t;
        const int dil = 1 << (2 * g), L = 128 << (2 * g);
        const float* cache = A.in[I_C128 + g] + (size_t)b * L * 2048 + h * 128;
        const float* newr = F.out + (g == 0 ? pg8::O_KV128S : (g == 1 ? pg8::O_KV512S : pg8::O_KV2048S)) + (size_t)b * 8 * 2048 + h * 128;
        const float c1 = 0.08838834764831845f * 1.4426950408889634f;
        const float cs = exp2f(-8.0f * (float)(g * 8 + h + 1) / 24.0f) * (float)dil * 1.4426950408889634f;
        const size_t row = (size_t)(TOKP + ms);
        { const unsigned qw = *(const unsigned*)(Q + row * 3072 + g * 1024 + h * 128 + 2 * lane);
          qs[2 * lane] = __uint_as_float(qw << 16) * c1; qs[2 * lane + 1] = __uint_as_float(qw & 0xffff0000u) * c1; }
        const float NEG = -__builtin_inff();
        {
            const int rsub = lane >> 5, dq = lane & 31;
            const f32x4 q4 = *(const LAS f32x4*)(qs + 4 * dq);
            for (int i0 = 0; i0 < 66; i0 += 22) {
                f32x4 kv[22];
#pragma unroll
                for (int u = 0; u < 22; ++u) {
                    const int j = 2 * (i0 + u) + rsub, idx = L + t - dil * j; const int ic = (idx >= 0 && j <= 128) ? idx : 0;
                    kv[u] = *(const f32x4*)((ic < L ? cache + (size_t)ic * 2048 : newr + (size_t)(ic - L) * 2048) + 4 * dq);
                }
                float sv[22];
#pragma unroll
                for (int u = 0; u < 22; ++u) sv[u] = (q4[0] * kv[u][0] + q4[1] * kv[u][1]) + (q4[2] * kv[u][2] + q4[3] * kv[u][3]);
#pragma unroll
                for (int st = 1; st < 32; st <<= 1) {
#pragma unroll
                    for (int u = 0; u < 22; ++u) sv[u] += __shfl_xor(sv[u], st);
                }
#pragma unroll
                for (int u = 0; u < 22; ++u) {
                    const int j = 2 * (i0 + u) + rsub, idx = L + t - dil * j; const bool valid = idx >= 0 && j <= 128;
                    if (dq == 0) ps[j] = valid ? sv[u] - cs * (float)j : NEG;
                }
            }
        }
        const int iC = L + t - dil * 128, cC = iC < 0 ? 0 : iC;
        const float* pC = cC < L ? cache + (size_t)cC * 2048 : newr + (size_t)(cC - L) * 2048;
        const int jA = lane, jB = lane + 64;
        const float sA = ps[jA], sB = ps[jB], sC = ps[128];
        float mx = fmaxf(fmaxf(sA, sB), sC);
#pragma unroll
        for (int o = 1; o < 64; o <<= 1) mx = fmaxf(mx, __shfl_xor(mx, o));
        const float eA = __builtin_amdgcn_exp2f(sA - mx), eB = __builtin_amdgcn_exp2f(sB - mx), eC = __builtin_amdgcn_exp2f(sC - mx);
        const float sum = wave_sum(eA + eB) + eC;
        ps[jA] = eA; ps[jB] = eB; if (lane == 0) ps[128] = eC;
        const int js = lane >> 4, dq = lane & 15;
        f32x4 o0 = {0.f, 0.f, 0.f, 0.f}, o1 = o0;
#pragma unroll 16
        for (int i = 0; i < 32; ++i) {
            const int j = js + 4 * i, idx = L + t - dil * j, ic = idx < 0 ? 0 : idx;
            const float pj = idx < 0 ? 0.f : ps[j];
            const float* vr = (ic < L ? cache + (size_t)ic * 2048 : newr + (size_t)(ic - L) * 2048) + 1024 + 8 * dq;
            const f32x4 v0 = *(const f32x4*)vr, v1 = *(const f32x4*)(vr + 4);
            o0 += v0 * pj; o1 += v1 * pj;
        }
        if (iC >= 0 && js == 0) { const float* vr = pC + 1024 + 8 * dq; const f32x4 v0 = *(const f32x4*)vr, v1 = *(const f32x4*)(vr + 4); o0 += v0 * eC; o1 += v1 * eC; }
#pragma unroll
        for (int st = 16; st <= 32; st <<= 1) {
#pragma unroll
            for (int c = 0; c < 4; ++c) { o0[c] += __shfl_xor(o0[c], st); o1[c] += __shfl_xor(o1[c], st); } }
        const float inv = 1.0f / sum;
        if (js == 0) pg8::st_bf16x8(OGA + ((size_t)g * MTOK + row) * 1024 + h * 128 + 8 * dq, o0 * inv, o1 * inv);
        if (lane == 0) LSE[((size_t)g * MTOK + row) * 8 + h] = mx + __log2f(sum);
    }
}

__device__ __forceinline__ void attn_merge_phase(Frame& F, const Args& A, const int nthr = NWAVES * 64) {
    const bf16* OGA = (const bf16*)(F.ws + WS_OGA); const float* LSE = (const float*)(F.ws + WS_LSE); bf16* O = (bf16*)(F.ws + WS_OATT);
    const int stride = F.G * nthr;
    for (int it0 = blockIdx.x * nthr + F.tid; it0 < MTOK * 128; it0 += 4 * stride) {
        v4u og[4][3]; float ls[4][3];
#pragma unroll
        for (int u = 0; u < 4; ++u) { const int it = it0 + u * stride; if (it < MTOK * 128) { const int row = it >> 7, c8 = it & 127, h = c8 >> 4;
#pragma unroll
            for (int g = 0; g < 3; ++g) { ls[u][g] = LSE[((size_t)g * MTOK + row) * 8 + h]; og[u][g] = *(const GAS v4u*)(OGA + ((size_t)g * MTOK + row) * 1024 + c8 * 8); } } }
#pragma unroll
        for (int u = 0; u < 4; ++u) { const int it = it0 + u * stride; if (it < MTOK * 128) { const int row = it >> 7, c8 = it & 127;
            const float mm = fmaxf(fmaxf(ls[u][0], ls[u][1]), ls[u][2]);
            float w0 = __builtin_amdgcn_exp2f(ls[u][0] - mm), w1 = __builtin_amdgcn_exp2f(ls[u][1] - mm), w2 = __builtin_amdgcn_exp2f(ls[u][2] - mm);
            const float inv = 1.0f / (w0 + w1 + w2); w0 *= inv; w1 *= inv; w2 *= inv;
            f32x4 a0, b0, a1, b1, a2, b2;
            pg8::EpiEw<0>::unpk(og[u][0], a0, b0); pg8::EpiEw<0>::unpk(og[u][1], a1, b1); pg8::EpiEw<0>::unpk(og[u][2], a2, b2);
            pg8::st_bf16x8(O + (size_t)row * 1024 + c8 * 8, a0 * w0 + a1 * w1 + a2 * w2, b0 * w0 + b1 * w1 + b2 * w2); } }
    }
}

typedef float f32x2v __attribute__((ext_vector_type(2)));
typedef unsigned u32x2v __attribute__((ext_vector_type(2)));
constexpr int HG_QD = 0, HG_KD = 8704, HG_KET = 17408, HG_VS = 27648, HG_DV = 36864, HG_PT = 37376, HG_OB = 41472, HG_END = 58368;
constexpr int HG_RS = 272, HG_KES = 80, HG_VSS = 288, HG_OBS = 528;
static_assert(HG_END <= MISC_OFF, "hgrn LDS map");
struct HgPre { float l0[4], l1[4]; unsigned kk[4], q[4]; v4u v, og; };
#define HG_BAR() do { asm volatile("s_waitcnt lgkmcnt(0)" ::: "memory"); __builtin_amdgcn_s_barrier(); asm volatile("" ::: "memory"); } while (0)
template <bool FULL>
__device__ __forceinline__ void hg_prefetch(Frame& F, HgPre& P, const size_t row0, const int nvalid, const int h) {
    const bf16* HQ = (const bf16*)(F.ws + WS_HQ); const bf16* KK = (const bf16*)(F.ws + WS_KK); const bf16* HI = (const bf16*)(F.ws + WS_HI); const float* LG = (const float*)(F.ws + WS_LG);
    const int k0 = 2 * F.lane, part = F.wave;
#pragma unroll
    for (int tt = 0; tt < 4; ++tt) {
        const int t = 4 * part + tt; const size_t off = (row0 + t) * 2048 + h * 128 + k0;
        P.l0[tt] = 0.f; P.l1[tt] = 0.f; P.kk[tt] = 0u; P.q[tt] = 0u;
        if (t < nvalid) { const f32x2v lv = *(const GAS f32x2v*)(LG + off); P.l0[tt] = lv.x; P.l1[tt] = lv.y; P.kk[tt] = *(const GAS unsigned*)(KK + off); if (FULL) P.q[tt] = *(const GAS unsigned*)(HQ + off); }
    }
    const int s = F.tid >> 4, ch = F.tid & 15;
    P.v = (v4u){0u, 0u, 0u, 0u}; P.og = (v4u){0u, 0u, 0u, 0u};
    if (s < nvalid) { P.v = *(const GAS v4u*)(HI + (row0 + s) * 2048 + h * 128 + ch * 8);
        if (FULL) P.og = *(const GAS v4u*)((const bf16*)(F.ws + WS_OG) + (row0 + s) * 2048 + h * 128 + ch * 8); }
}
template <bool FULL>
__device__ __forceinline__ void hgrn_chunk(Frame& F, f32x4 (&S)[8], float& bs0, float& bs1, HgPre& P, const size_t row0, const int nvalid, const int h, const float* ghg,
                                           const bool has_next, const size_t row0_next, const int nvalid_next, const f32x4 w0 = (f32x4){0.f, 0.f, 0.f, 0.f}, const f32x4 w1 = (f32x4){0.f, 0.f, 0.f, 0.f}) {
    const bf16* HQ = (const bf16*)(F.ws + WS_HQ); const bf16* KK = (const bf16*)(F.ws + WS_KK); const bf16* HI = (const bf16*)(F.ws + WS_HI); const bf16* OG = (const bf16*)(F.ws + WS_OG);
    const float* LG = (const float*)(F.ws + WS_LG); bf16* OHG = (bf16*)(F.ws + WS_OHG);
    const int tid = F.tid, lane = F.lane, w = F.wave, l15 = lane & 15, kq = lane >> 4;
    LAS unsigned char* lds = F.lds;
    const int kp = lane, part = w, k0 = 2 * kp;
    float c0[4], c1[4]; unsigned kkw[4], qw[4]; v4u og_cur;
    {
        float a0 = 0.f, a1 = 0.f;
#pragma unroll
        for (int tt = 0; tt < 4; ++tt) { a0 += P.l0[tt]; a1 += P.l1[tt]; c0[tt] = a0; c1[tt] = a1; kkw[tt] = P.kk[tt]; qw[tt] = P.q[tt]; }
        *(LAS f32x2v*)(lds + HG_PT + (part * 128 + k0) * 4) = (f32x2v){a0, a1};
        const int s = tid >> 4, ch = tid & 15;
        *(LAS v4u*)(lds + HG_VS + s * HG_VSS + ch * 16) = P.v;
        asm volatile("" ::: "memory");
        og_cur = P.og;
        if (has_next) hg_prefetch<FULL>(F, P, row0_next, nvalid_next, h);
    }
    HG_BAR();
    {
        float base0 = 0.f, base1 = 0.f, tot0 = 0.f, tot1 = 0.f;
#pragma unroll
        for (int p = 0; p < 8; ++p) { const f32x2v pv = *(const LAS f32x2v*)(lds + HG_PT + (p * 128 + k0) * 4); if (p < part) { base0 += pv.x; base1 += pv.y; } tot0 += pv.x; tot1 += pv.y; }
        unsigned ke0[2], ke1[2];
        float e0[4], e1[4];
#pragma unroll
        for (int tt = 0; tt < 4; ++tt) {
            const int t = 4 * part + tt;
            const float b0 = base0 + c0[tt], b1 = base1 + c1[tt];
            const float kk0 = __uint_as_float(kkw[tt] << 16), kk1 = __uint_as_float(kkw[tt] & 0xffff0000u);
            if (FULL) {
                const float q0 = __uint_as_float(qw[tt] << 16), q1 = __uint_as_float(qw[tt] & 0xffff0000u);
                *(LAS unsigned*)(lds + HG_QD + t * HG_RS + k0 * 2) = cvtpk(q0 * __expf(b0), q1 * __expf(b1));
                *(LAS unsigned*)(lds + HG_KD + t * HG_RS + k0 * 2) = cvtpk(kk0 * __expf(-b0), kk1 * __expf(-b1));
            }
            e0[tt] = kk0 * __expf(tot0 - b0); e1[tt] = kk1 * __expf(tot1 - b1);
        }
        ke0[0] = cvtpk(e0[0], e0[1]); ke0[1] = cvtpk(e0[2], e0[3]); ke1[0] = cvtpk(e1[0], e1[1]); ke1[1] = cvtpk(e1[2], e1[3]);
        *(LAS u32x2v*)(lds + HG_KET + k0 * HG_KES + part * 8) = (u32x2v){ke0[0], ke0[1]};
        *(LAS u32x2v*)(lds + HG_KET + (k0 + 1) * HG_KES + part * 8) = (u32x2v){ke1[0], ke1[1]};
        if (part == 0) { *(LAS f32x2v*)(lds + HG_DV + k0 * 4) = (f32x2v){__expf(tot0), __expf(tot1)}; bs0 += tot0; bs1 += tot1; }
    }
    HG_BAR();
    const unsigned ldsb = (unsigned)(size_t)lds;
    const unsigned vcol = (unsigned)((16 * w + 4 * (l15 & 3)) * 2);
    const unsigned vbA = ldsb + HG_VS + (4 * kq + (l15 >> 2)) * HG_VSS + vcol;
    const unsigned vbB = ldsb + HG_VS + (8 * kq + (l15 >> 2)) * HG_VSS + vcol;
#define PK8(L, H) (bf16x8){L[0], L[1], L[2], L[3], H[0], H[1], H[2], H[3]}
    f32x4 o0 = {0.f, 0.f, 0.f, 0.f}, o1 = {0.f, 0.f, 0.f, 0.f};
    if (FULL) {
        f32x4 X00 = {0.f, 0.f, 0.f, 0.f}, X01 = X00, X11 = X00;
#pragma unroll
        for (int ks = 0; ks < 4; ++ks) {
            const bf16x8 ka0 = *(const LAS bf16x8*)(lds + HG_KD + l15 * HG_RS + (32 * ks + 8 * kq) * 2), ka1 = *(const LAS bf16x8*)(lds + HG_KD + (16 + l15) * HG_RS + (32 * ks + 8 * kq) * 2);
            const bf16x8 qb0 = *(const LAS bf16x8*)(lds + HG_QD + l15 * HG_RS + (32 * ks + 8 * kq) * 2), qb1 = *(const LAS bf16x8*)(lds + HG_QD + (16 + l15) * HG_RS + (32 * ks + 8 * kq) * 2);
            X00 = MFMA16(ka0, qb0, X00); X01 = MFMA16(ka0, qb1, X01); X11 = MFMA16(ka1, qb1, X11);
        }
#pragma unroll
        for (int r = 0; r < 4; ++r) { const bool keep = (4 * kq + r) <= l15; X00[r] = keep ? X00[r] : 0.f; X11[r] = keep ? X11[r] : 0.f; }
        v4u xa0, xa1;
        xa0.x = cvtpk(X00[0], X00[1]); xa0.y = cvtpk(X00[2], X00[3]); xa0.z = 0u; xa0.w = 0u;
        xa1.x = cvtpk(X01[0], X01[1]); xa1.y = cvtpk(X01[2], X01[3]); xa1.z = cvtpk(X11[0], X11[1]); xa1.w = cvtpk(X11[2], X11[3]);
#pragma unroll
        for (int ks = 0; ks < 4; ++ks) {
            v4u sb; sb.x = cvtpk(S[2 * ks][0], S[2 * ks][1]); sb.y = cvtpk(S[2 * ks][2], S[2 * ks][3]); sb.z = cvtpk(S[2 * ks + 1][0], S[2 * ks + 1][1]); sb.w = cvtpk(S[2 * ks + 1][2], S[2 * ks + 1][3]);
            const bf16x8 Bs = __builtin_bit_cast(bf16x8, sb);
            const s16x4 qa0l = *(const LAS s16x4*)(lds + HG_QD + l15 * HG_RS + (32 * ks + 4 * kq) * 2), qa0h = *(const LAS s16x4*)(lds + HG_QD + l15 * HG_RS + (32 * ks + 16 + 4 * kq) * 2);
            const s16x4 qa1l = *(const LAS s16x4*)(lds + HG_QD + (16 + l15) * HG_RS + (32 * ks + 4 * kq) * 2), qa1h = *(const LAS s16x4*)(lds + HG_QD + (16 + l15) * HG_RS + (32 * ks + 16 + 4 * kq) * 2);
            o0 = MFMA16(PK8(qa0l, qa0h), Bs, o0); o1 = MFMA16(PK8(qa1l, qa1h), Bs, o1);
        }
        const s16x4 vp0 = tr_read<0>(vbA), vp1 = tr_read<16 * HG_VSS>(vbA);
        asm volatile("s_waitcnt lgkmcnt(0)" ::: "memory"); __builtin_amdgcn_sched_barrier(0);
        const bf16x8 Vp = PK8(vp0, vp1);
        o0 = MFMA16(__builtin_bit_cast(bf16x8, xa0), Vp, o0); o1 = MFMA16(__builtin_bit_cast(bf16x8, xa1), Vp, o1);
    }
    {
        const s16x4 vn0 = tr_read<0>(vbB), vn1 = tr_read<4 * HG_VSS>(vbB);
        asm volatile("s_waitcnt lgkmcnt(0)" ::: "memory"); __builtin_amdgcn_sched_barrier(0);
        const bf16x8 Vn = PK8(vn0, vn1);
#pragma unroll
        for (int kt = 0; kt < 8; ++kt) {
            const f32x4 dk = *(const LAS f32x4*)(lds + HG_DV + (16 * kt + 4 * kq) * 4);
            const bf16x8 a = *(const LAS bf16x8*)(lds + HG_KET + (16 * kt + l15) * HG_KES + 16 * kq);
            S[kt] = MFMA16(a, Vn, S[kt] * dk);
        }
    }
#undef PK8
    if (FULL) {
#pragma unroll
        for (int r = 0; r < 4; ++r) {
            *(LAS float*)(lds + HG_OB + (4 * kq + r) * HG_OBS + (16 * w + l15) * 4) = o0[r];
            *(LAS float*)(lds + HG_OB + (16 + 4 * kq + r) * HG_OBS + (16 * w + l15) * 4) = o1[r];
        }
    }
    HG_BAR();
    if (FULL) {
        const int t = tid >> 4, c = tid & 15;
        const f32x4 a = *(const LAS f32x4*)(lds + HG_OB + t * HG_OBS + c * 32), b = *(const LAS f32x4*)(lds + HG_OB + t * HG_OBS + c * 32 + 16);
        float ss = (a[0] * a[0] + a[1] * a[1]) + (a[2] * a[2] + a[3] * a[3]) + (b[0] * b[0] + b[1] * b[1]) + (b[2] * b[2] + b[3] * b[3]);
        ss += __shfl_xor(ss, 1); ss += __shfl_xor(ss, 2); ss += __shfl_xor(ss, 4); ss += __shfl_xor(ss, 8);
        if (t < nvalid) {
            const float rstd = rsqrtf(ss * (1.0f / 128.0f) + 1e-6f);
            const size_t off = (row0 + t) * 2048 + h * 128 + c * 8;
            f32x4 ga, gb; pg8::EpiEw<0>::unpk(og_cur, ga, gb);
            pg8::st_bf16x8(OHG + off, a * rstd * w0 * ga, b * rstd * w1 * gb);
        }
    }
}

__device__ __forceinline__ void hgrn_pass_a(Frame& F, const Args& A) {
    float* SST = (float*)(F.ws + WS_SST); float* DSC = (float*)(F.ws + WS_DSC);
    const int lane = F.lane, w = F.wave, l15 = lane & 15, kq = lane >> 4;
    for (int unit = blockIdx.x; unit < 512; unit += F.G) {
        const int h = unit >> 5, sc = unit & 31;
        f32x4 S[8];
#pragma unroll
        for (int kt = 0; kt < 8; ++kt) S[kt] = (f32x4){0.f, 0.f, 0.f, 0.f};
        float bs0 = 0.f, bs1 = 0.f;
        HgPre P; hg_prefetch<false>(F, P, (size_t)sc * 256, 32, h);
        for (int c = 0; c < 8; ++c) hgrn_chunk<false>(F, S, bs0, bs1, P, (size_t)sc * 256 + c * 32, 32, h, nullptr, c + 1 < 8, (size_t)sc * 256 + (c + 1) * 32, 32);
        float* dst = SST + (size_t)(h * 32 + sc) * 16384;
#pragma unroll
        for (int kt = 0; kt < 8; ++kt)
#pragma unroll
            for (int r = 0; r < 4; ++r) dst[(16 * kt + 4 * kq + r) * 128 + 16 * w + l15] = S[kt][r];
        if (w == 0) *(f32x2v*)(DSC + (size_t)(h * 32 + sc) * 128 + 2 * lane) = (f32x2v){__expf(bs0), __expf(bs1)};
    }
}
__device__ __forceinline__ void hgrn_scan(Frame& F, const Args& A, const int nthr = NWAVES * 64) {
    float* SST = (float*)(F.ws + WS_SST); const float* DSC = (const float*)(F.ws + WS_DSC);
    for (int idx = blockIdx.x * nthr + F.tid; idx < 16 * 16384; idx += F.G * nthr) {
        const int h = idx >> 14, e = idx & 16383, k = e >> 7;
        float s = 0.f, lv[32], dv[32];
#pragma unroll
        for (int sc = 0; sc < 32; ++sc) { lv[sc] = SST[(size_t)(h * 32 + sc) * 16384 + e]; dv[sc] = DSC[(h * 32 + sc) * 128 + k]; }
#pragma unroll
        for (int sc = 0; sc < 32; ++sc) { SST[(size_t)(h * 32 + sc) * 16384 + e] = s; s = dv[sc] * s + lv[sc]; }
        F.out[pg8::O_STP + (size_t)h * 16384 + e] = s;
    }
}
__device__ __forceinline__ void hgrn_pass_c(Frame& F, const Args& A) {
    const float* SST = (const float*)(F.ws + WS_SST);
    const int lane = F.lane, w = F.wave, l15 = lane & 15, kq = lane >> 4;
    const float* ghg = A.in[I_GHG];
    const f32x4 gw0 = *(const f32x4*)(ghg + (F.tid & 15) * 8), gw1 = *(const f32x4*)(ghg + (F.tid & 15) * 8 + 4);
    for (int unit = blockIdx.x; unit < 1024; unit += F.G) {
        int h, nch, nvalid; size_t row0; const float* sin; float* sout = nullptr;
        if (unit < 512) { h = unit >> 5; const int sc = unit & 31; row0 = (size_t)sc * 256; nch = 8; nvalid = 32; sin = SST + (size_t)(h * 32 + sc) * 16384; }
        else { const int u2 = unit - 512, b = u2 >> 4; h = u2 & 15; row0 = (size_t)TOKP + b * 8; nch = 1; nvalid = 8; sin = A.in[I_ST] + (size_t)(b * 16 + h) * 16384; sout = F.out + pg8::O_STS + (size_t)(b * 16 + h) * 16384; }
        f32x4 S[8];
#pragma unroll
        for (int kt = 0; kt < 8; ++kt)
#pragma unroll
            for (int r = 0; r < 4; ++r) S[kt][r] = sin[(16 * kt + 4 * kq + r) * 128 + 16 * w + l15];
        float bs0 = 0.f, bs1 = 0.f;
        HgPre P; hg_prefetch<true>(F, P, row0, nvalid, h);
        for (int c = 0; c < nch; ++c) hgrn_chunk<true>(F, S, bs0, bs1, P, row0 + (size_t)c * 32, nvalid, h, ghg, c + 1 < nch, row0 + (size_t)(c + 1) * 32, nvalid, gw0, gw1);
        if (sout) {
#pragma unroll
            for (int kt = 0; kt < 8; ++kt)
#pragma unroll
                for (int r = 0; r < 4; ++r) sout[(16 * kt + 4 * kq + r) * 128 + 16 * w + l15] = S[kt][r];
        }
    }
}

constexpr int HG_SET = HG_END;
static_assert(2 * HG_SET <= TAB_OFF, "hgrn LDS map (two sets)");
template <bool FULL>
__device__ __forceinline__ void hgrn_chunk2(Frame& F, f32x4 (&S)[2][8], float (&bs0)[2], float (&bs1)[2], HgPre (&P)[2], const size_t (&row0)[2], const int nvalid, const int (&h)[2],
                                            const bool has_next, const size_t (&row0n)[2], const int nvalid_next, const f32x4 w0 = (f32x4){0.f, 0.f, 0.f, 0.f}, const f32x4 w1 = (f32x4){0.f, 0.f, 0.f, 0.f}) {
    bf16* OHG = (bf16*)(F.ws + WS_OHG);
    const int tid = F.tid, lane = F.lane, w = F.wave, l15 = lane & 15, kq = lane >> 4;
    LAS unsigned char* lds0 = F.lds;
    const int kp = lane, part = w, k0 = 2 * kp;
    float c0[2][4], c1[2][4]; unsigned kkw[2][4], qw[2][4]; v4u og_cur[2];
#pragma unroll
    for (int u = 0; u < 2; ++u) {
        LAS unsigned char* lds = lds0 + u * HG_SET;
        float a0 = 0.f, a1 = 0.f;
#pragma unroll
        for (int tt = 0; tt < 4; ++tt) { a0 += P[u].l0[tt]; a1 += P[u].l1[tt]; c0[u][tt] = a0; c1[u][tt] = a1; kkw[u][tt] = P[u].kk[tt]; qw[u][tt] = P[u].q[tt]; }
        *(LAS f32x2v*)(lds + HG_PT + (part * 128 + k0) * 4) = (f32x2v){a0, a1};
        const int s = tid >> 4, ch = tid & 15;
        *(LAS v4u*)(lds + HG_VS + s * HG_VSS + ch * 16) = P[u].v;
        og_cur[u] = P[u].og;
    }
    asm volatile("" ::: "memory");
    if (has_next) {
#pragma unroll
        for (int u = 0; u < 2; ++u) hg_prefetch<FULL>(F, P[u], row0n[u], nvalid_next, h[u]);
    }
    HG_BAR();
#pragma unroll
    for (int u = 0; u < 2; ++u) {
        LAS unsigned char* lds = lds0 + u * HG_SET;
        float base0 = 0.f, base1 = 0.f, tot0 = 0.f, tot1 = 0.f;
#pragma unroll
        for (int p = 0; p < 8; ++p) { const f32x2v pv = *(const LAS f32x2v*)(lds + HG_PT + (p * 128 + k0) * 4); if (p < part) { base0 += pv.x; base1 += pv.y; } tot0 += pv.x; tot1 += pv.y; }
        unsigned ke0[2], ke1[2];
        float e0[4], e1[4];
#pragma unroll
        for (int tt = 0; tt < 4; ++tt) {
            const int t = 4 * part + tt;
            const float b0 = base0 + c0[u][tt], b1 = base1 + c1[u][tt];
            const float kk0 = __uint_as_float(kkw[u][tt] << 16), kk1 = __uint_as_float(kkw[u][tt] & 0xffff0000u);
            if (FULL) {
                const float q0 = __uint_as_float(qw[u][tt] << 16), q1 = __uint_as_float(qw[u][tt] & 0xffff0000u);
                *(LAS unsigned*)(lds + HG_QD + t * HG_RS + k0 * 2) = cvtpk(q0 * __expf(b0), q1 * __expf(b1));
                *(LAS unsigned*)(lds + HG_KD + t * HG_RS + k0 * 2) = cvtpk(kk0 * __expf(-b0), kk1 * __expf(-b1));
            }
            e0[tt] = kk0 * __expf(tot0 - b0); e1[tt] = kk1 * __expf(tot1 - b1);
        }
        ke0[0] = cvtpk(e0[0], e0[1]); ke0[1] = cvtpk(e0[2], e0[3]); ke1[0] = cvtpk(e1[0], e1[1]); ke1[1] = cvtpk(e1[2], e1[3]);
        *(LAS u32x2v*)(lds + HG_KET + k0 * HG_KES + part * 8) = (u32x2v){ke0[0], ke0[1]};
        *(LAS u32x2v*)(lds + HG_KET + (k0 + 1) * HG_KES + part * 8) = (u32x2v){ke1[0], ke1[1]};
        if (part == 0) { *(LAS f32x2v*)(lds + HG_DV + k0 * 4) = (f32x2v){__expf(tot0), __expf(tot1)}; bs0[u] += tot0; bs1[u] += tot1; }
    }
    HG_BAR();
    const unsigned ldsb = (unsigned)(size_t)lds0;
    const unsigned vcol = (unsigned)((16 * w + 4 * (l15 & 3)) * 2);
    const unsigned vbA = ldsb + HG_VS + (4 * kq + (l15 >> 2)) * HG_VSS + vcol;
    const unsigned vbB = ldsb + HG_VS + (8 * kq + (l15 >> 2)) * HG_VSS + vcol;
#define PK8(L, H) (bf16x8){L[0], L[1], L[2], L[3], H[0], H[1], H[2], H[3]}
    f32x4 o0[2], o1[2];
#pragma unroll
    for (int u = 0; u < 2; ++u) { o0[u] = (f32x4){0.f, 0.f, 0.f, 0.f}; o1[u] = o0[u]; }
    if (FULL) {
        f32x4 X00[2], X01[2], X11[2];
#pragma unroll
        for (int u = 0; u < 2; ++u) { X00[u] = (f32x4){0.f, 0.f, 0.f, 0.f}; X01[u] = X00[u]; X11[u] = X00[u]; }
#pragma unroll
        for (int ks = 0; ks < 4; ++ks)
#pragma unroll
            for (int u = 0; u < 2; ++u) {
                LAS unsigned char* lds = lds0 + u * HG_SET;
                const bf16x8 ka0 = *(const LAS bf16x8*)(lds + HG_KD + l15 * HG_RS + (32 * ks + 8 * kq) * 2), ka1 = *(const LAS bf16x8*)(lds + HG_KD + (16 + l15) * HG_RS + (32 * ks + 8 * kq) * 2);
                const bf16x8 qb0 = *(const LAS bf16x8*)(lds + HG_QD + l15 * HG_RS + (32 * ks + 8 * kq) * 2), qb1 = *(const LAS bf16x8*)(lds + HG_QD + (16 + l15) * HG_RS + (32 * ks + 8 * kq) * 2);
                X00[u] = MFMA16(ka0, qb0, X00[u]); X01[u] = MFMA16(ka0, qb1, X01[u]); X11[u] = MFMA16(ka1, qb1, X11[u]);
            }
        v4u xa0[2], xa1[2];
#pragma unroll
        for (int u = 0; u < 2; ++u) {
#pragma unroll
            for (int r = 0; r < 4; ++r) { const bool keep = (4 * kq + r) <= l15; X00[u][r] = keep ? X00[u][r] : 0.f; X11[u][r] = keep ? X11[u][r] : 0.f; }
            xa0[u].x = cvtpk(X00[u][0], X00[u][1]); xa0[u].y = cvtpk(X00[u][2], X00[u][3]); xa0[u].z = 0u; xa0[u].w = 0u;
            xa1[u].x = cvtpk(X01[u][0], X01[u][1]); xa1[u].y = cvtpk(X01[u][2], X01[u][3]); xa1[u].z = cvtpk(X11[u][0], X11[u][1]); xa1[u].w = cvtpk(X11[u][2], X11[u][3]);
        }
#pragma unroll
        for (int ks = 0; ks < 4; ++ks)
#pragma unroll
            for (int u = 0; u < 2; ++u) {
                LAS unsigned char* lds = lds0 + u * HG_SET;
                v4u sb; sb.x = cvtpk(S[u][2 * ks][0], S[u][2 * ks][1]); sb.y = cvtpk(S[u][2 * ks][2], S[u][2 * ks][3]); sb.z = cvtpk(S[u][2 * ks + 1][0], S[u][2 * ks + 1][1]); sb.w = cvtpk(S[u][2 * ks + 1][2], S[u][2 * ks + 1][3]);
                const bf16x8 Bs = __builtin_bit_cast(bf16x8, sb);
                const s16x4 qa0l = *(const LAS s16x4*)(lds + HG_QD + l15 * HG_RS + (32 * ks + 4 * kq) * 2), qa0h = *(const LAS s16x4*)(lds + HG_QD + l15 * HG_RS + (32 * ks + 16 + 4 * kq) * 2);
                const s16x4 qa1l = *(const LAS s16x4*)(lds + HG_QD + (16 + l15) * HG_RS + (32 * ks + 4 * kq) * 2), qa1h = *(const LAS s16x4*)(lds + HG_QD + (16 + l15) * HG_RS + (32 * ks + 16 + 4 * kq) * 2);
                o0[u] = MFMA16(PK8(qa0l, qa0h), Bs, o0[u]); o1[u] = MFMA16(PK8(qa1l, qa1h), Bs, o1[u]);
            }
        const s16x4 vp00 = tr_read<0>(vbA), vp01 = tr_read<16 * HG_VSS>(vbA), vp10 = tr_read<0>(vbA + HG_SET), vp11 = tr_read<16 * HG_VSS>(vbA + HG_SET);
        asm volatile("s_waitcnt lgkmcnt(0)" ::: "memory"); __builtin_amdgcn_sched_barrier(0);
        const bf16x8 Vp0 = PK8(vp00, vp01), Vp1 = PK8(vp10, vp11);
        o0[0] = MFMA16(__builtin_bit_cast(bf16x8, xa0[0]), Vp0, o0[0]); o1[0] = MFMA16(__builtin_bit_cast(bf16x8, xa1[0]), Vp0, o1[0]);
        o0[1] = MFMA16(__builtin_bit_cast(bf16x8, xa0[1]), Vp1, o0[1]); o1[1] = MFMA16(__builtin_bit_cast(bf16x8, xa1[1]), Vp1, o1[1]);
    }
    {
        const s16x4 vn00 = tr_read<0>(vbB), vn01 = tr_read<4 * HG_VSS>(vbB), vn10 = tr_read<0>(vbB + HG_SET), vn11 = tr_read<4 * HG_VSS>(vbB + HG_SET);
        asm volatile("s_waitcnt lgkmcnt(0)" ::: "memory"); __builtin_amdgcn_sched_barrier(0);
        const bf16x8 Vn0 = PK8(vn00, vn01), Vn1 = PK8(vn10, vn11);
#pragma unroll
        for (int kt = 0; kt < 8; ++kt)
#pragma unroll
            for (int u = 0; u < 2; ++u) {
                LAS unsigned char* lds = lds0 + u * HG_SET;
                const f32x4 dk = *(const LAS f32x4*)(lds + HG_DV + (16 * kt + 4 * kq) * 4);
                const bf16x8 a = *(const LAS bf16x8*)(lds + HG_KET + (16 * kt + l15) * HG_KES + 16 * kq);
                S[u][kt] = MFMA16(a, u ? Vn1 : Vn0, S[u][kt] * dk);
            }
    }
#undef PK8
    if (FULL) {
#pragma unroll
        for (int u = 0; u < 2; ++u)
#pragma unroll
            for (int r = 0; r < 4; ++r) {
                *(LAS float*)(lds0 + u * HG_SET + HG_OB + (4 * kq + r) * HG_OBS + (16 * w + l15) * 4) = o0[u][r];
                *(LAS float*)(lds0 + u * HG_SET + HG_OB + (16 + 4 * kq + r) * HG_OBS + (16 * w + l15) * 4) = o1[u][r];
            }
    }
    HG_BAR();
    if (FULL) {
        const int t = tid >> 4, c = tid & 15;
        f32x4 a[2], b[2]; float ss[2];
#pragma unroll
        for (int u = 0; u < 2; ++u) {
            a[u] = *(const LAS f32x4*)(lds0 + u * HG_SET + HG_OB + t * HG_OBS + c * 32); b[u] = *(const LAS f32x4*)(lds0 + u * HG_SET + HG_OB + t * HG_OBS + c * 32 + 16);
            ss[u] = (a[u][0] * a[u][0] + a[u][1] * a[u][1]) + (a[u][2] * a[u][2] + a[u][3] * a[u][3]) + (b[u][0] * b[u][0] + b[u][1] * b[u][1]) + (b[u][2] * b[u][2] + b[u][3] * b[u][3]);
        }
#pragma unroll
        for (int st = 1; st < 16; st <<= 1) { const float x0 = __shfl_xor(ss[0], st), x1 = __shfl_xor(ss[1], st); ss[0] += x0; ss[1] += x1; }
        if (t < nvalid) {
#pragma unroll
            for (int u = 0; u < 2; ++u) {
                const float rstd = rsqrtf(ss[u] * (1.0f / 128.0f) + 1e-6f);
                const size_t off = (row0[u] + t) * 2048 + h[u] * 128 + c * 8;
                f32x4 ga, gb; pg8::EpiEw<0>::unpk(og_cur[u], ga, gb);
                pg8::st_bf16x8(OHG + off, a[u] * rstd * w0 * ga, b[u] * rstd * w1 * gb);
            }
        }
    }
}
__device__ __forceinline__ void hgrn_pass_a2(Frame& F, const Args& A) {
    float* SST = (float*)(F.ws + WS_SST); float* DSC = (float*)(F.ws + WS_DSC);
    const int lane = F.lane, w = F.wave, l15 = lane & 15, kq = lane >> 4;
    const int un[2] = {(int)blockIdx.x, (int)blockIdx.x + 256};
    const int h[2] = {un[0] >> 5, un[1] >> 5}, sc = un[0] & 31;
    f32x4 S[2][8];
#pragma unroll
    for (int u = 0; u < 2; ++u)
#pragma unroll
        for (int kt = 0; kt < 8; ++kt) S[u][kt] = (f32x4){0.f, 0.f, 0.f, 0.f};
    float bs0[2] = {0.f, 0.f}, bs1[2] = {0.f, 0.f};
    HgPre P[2];
#pragma unroll
    for (int u = 0; u < 2; ++u) hg_prefetch<false>(F, P[u], (size_t)sc * 256, 32, h[u]);
    for (int c = 0; c < 8; ++c) {
        const size_t r0[2] = {(size_t)sc * 256 + c * 32, (size_t)sc * 256 + c * 32}, rn[2] = {r0[0] + 32, r0[1] + 32};
        hgrn_chunk2<false>(F, S, bs0, bs1, P, r0, 32, h, c + 1 < 8, rn, 32);
    }
#pragma unroll
    for (int u = 0; u < 2; ++u) {
        float* dst = SST + (size_t)(h[u] * 32 + sc) * 16384;
#pragma unroll
        for (int kt = 0; kt < 8; ++kt)
#pragma unroll
            for (int r = 0; r < 4; ++r) dst[(16 * kt + 4 * kq + r) * 128 + 16 * w + l15] = S[u][kt][r];
        if (w == 0) *(f32x2v*)(DSC + (size_t)(h[u] * 32 + sc) * 128 + 2 * lane) = (f32x2v){__expf(bs0[u]), __expf(bs1[u])};
    }
}
__device__ __forceinline__ void hgrn_pass_c2(Frame& F, const Args& A) {
    const float* SST = (const float*)(F.ws + WS_SST);
    const int lane = F.lane, w = F.wave, l15 = lane & 15, kq = lane >> 4;
    const float* ghg = A.in[I_GHG];
    const f32x4 gw0 = *(const f32x4*)(ghg + (F.tid & 15) * 8), gw1 = *(const f32x4*)(ghg + (F.tid & 15) * 8 + 4);
    for (int kind = 0; kind < 2; ++kind) {
        int h[2], nch, nvalid; size_t row0[2]; const float* sin[2]; float* sout[2] = {nullptr, nullptr};
#pragma unroll
        for (int u = 0; u < 2; ++u) {
            const int u2 = (int)blockIdx.x + 256 * u;
            if (kind == 0) { h[u] = u2 >> 5; const int sc = u2 & 31; row0[u] = (size_t)sc * 256; sin[u] = SST + (size_t)(h[u] * 32 + sc) * 16384; }
            else { const int b = u2 >> 4; h[u] = u2 & 15; row0[u] = (size_t)TOKP + b * 8; sin[u] = A.in[I_ST] + (size_t)(b * 16 + h[u]) * 16384; sout[u] = F.out + pg8::O_STS + (size_t)(b * 16 + h[u]) * 16384; }
        }
        nch = kind == 0 ? 8 : 1; nvalid = kind == 0 ? 32 : 8;
        f32x4 S[2][8];
        int lo = ((4 * kq) * 128 + 16 * w + l15) * 4; asm volatile("" : "+v"(lo));
#pragma unroll
        for (int u = 0; u < 2; ++u) {
            const GAS char* sb = (const GAS char*)sin[u];
#pragma unroll
            for (int kt = 0; kt < 8; ++kt)
#pragma unroll
                for (int r = 0; r < 4; ++r) S[u][kt][r] = *(const GAS float*)(sb + (unsigned)(lo + (16 * kt + r) * 512));
        }
        float bs0[2] = {0.f, 0.f}, bs1[2] = {0.f, 0.f};
        HgPre P[2];
#pragma unroll
        for (int u = 0; u < 2; ++u) hg_prefetch<true>(F, P[u], row0[u], nvalid, h[u]);
        for (int c = 0; c < nch; ++c) {
            const size_t r0[2] = {row0[0] + (size_t)c * 32, row0[1] + (size_t)c * 32}, rn[2] = {r0[0] + 32, r0[1] + 32};
            hgrn_chunk2<true>(F, S, bs0, bs1, P, r0, nvalid, h, c + 1 < nch, rn, nvalid, gw0, gw1);
        }
        if (kind == 1) {
            asm volatile("" : "+v"(lo));
#pragma unroll
            for (int u = 0; u < 2; ++u) {
                GAS char* sb = (GAS char*)sout[u];
#pragma unroll
                for (int kt = 0; kt < 8; ++kt)
#pragma unroll
                    for (int r = 0; r < 4; ++r) *(GAS float*)(sb + (unsigned)(lo + (16 * kt + r) * 512)) = S[u][kt][r];
            }
        }
    }
}

__device__ __forceinline__ void hgrn_naive_phase(Frame& F, const Args& A) {
    const bf16* HQ = (const bf16*)(F.ws + WS_HQ); const bf16* KK = (const bf16*)(F.ws + WS_KK); const bf16* HI = (const bf16*)(F.ws + WS_HI); const bf16* OG = (const bf16*)(F.ws + WS_OG);
    const float* LG = (const float*)(F.ws + WS_LG); bf16* OHG = (bf16*)(F.ws + WS_OHG);
    const float* ghg = A.in[I_GHG];
    LAS float* qs = (LAS float*)(F.lds);
    LAS float* ks = qs + 1024; LAS float* gs = ks + 1024; LAS float* vs = gs + 1024;
    LAS float* part = vs + 1024;
    const int tid = F.tid, v = tid & 127, kq = tid >> 7;
    for (int unit = blockIdx.x; unit < 16 + 512; unit += F.G) {
        int h, row_base, T; float* sout; const float* s0 = nullptr;
        if (unit < 16) { h = unit; row_base = 0; T = TOKP; sout = F.out + pg8::O_STP + (size_t)h * 16384; }
        else { const int b = (unit - 16) >> 4; h = (unit - 16) & 15; row_base = TOKP + b * 8; T = 8; sout = F.out + pg8::O_STS + (size_t)(b * 16 + h) * 16384; s0 = A.in[I_ST] + (size_t)(b * 16 + h) * 16384; }
        float S[32];
#pragma unroll
        for (int i = 0; i < 32; ++i) S[i] = s0 ? s0[(size_t)(32 * kq + i) * 128 + v] : 0.f;
        for (int t0 = 0; t0 < T; t0 += 8) {
            __syncthreads();
#pragma unroll
            for (int e = 0; e < 2; ++e) { const int idx = tid + 512 * e, tt = idx >> 7, k = idx & 127; const size_t off = (size_t)(row_base + t0 + tt) * 2048 + h * 128 + k;
                qs[idx] = bf2f(HQ[off]); ks[idx] = bf2f(KK[off]); gs[idx] = __expf(LG[off]); vs[idx] = bf2f(HI[off]); }
            __syncthreads();
#pragma unroll 1
            for (int tt = 0; tt < 8; ++tt) {
                const float vv = vs[tt * 128 + v]; float po = 0.f;
#pragma unroll
                for (int i = 0; i < 32; ++i) { const int k = 32 * kq + i; S[i] = gs[tt * 128 + k] * S[i] + ks[tt * 128 + k] * vv; po += S[i] * qs[tt * 128 + k]; }
                part[(tt * 4 + kq) * 128 + v] = po;
            }
            __syncthreads();
            {
                const int tt = F.wave, l = F.lane; const size_t ro = (size_t)(row_base + t0 + tt) * 2048 + h * 128;
                const float a0 = part[(tt * 4 + 0) * 128 + 2 * l] + part[(tt * 4 + 1) * 128 + 2 * l] + part[(tt * 4 + 2) * 128 + 2 * l] + part[(tt * 4 + 3) * 128 + 2 * l];
                const float a1 = part[(tt * 4 + 0) * 128 + 2 * l + 1] + part[(tt * 4 + 1) * 128 + 2 * l + 1] + part[(tt * 4 + 2) * 128 + 2 * l + 1] + part[(tt * 4 + 3) * 128 + 2 * l + 1];
                const float rstd = rsqrtf(wave_sum(a0 * a0 + a1 * a1) * (1.0f / 128.0f) + 1e-6f);
                const unsigned ogw = *(const unsigned*)(OG + ro + 2 * l);
                *(unsigned*)(OHG + ro + 2 * l) = pk2(a0 * rstd * ghg[2 * l] * __uint_as_float(ogw << 16), a1 * rstd * ghg[2 * l + 1] * __uint_as_float(ogw & 0xffff0000u));
            }
        }
#pragma unroll
        for (int i = 0; i < 32; ++i) sout[(size_t)(32 * kq + i) * 128 + v] = S[i];
        __syncthreads();
    }
}

#ifndef WGM_A
#define WGM_A 4
#endif
#ifndef WGM_B
#define WGM_B 4
#endif
#ifndef WGM_9
#define WGM_9 4
#endif
#ifndef WGM_11
#define WGM_11 4
#endif
__global__ void __launch_bounds__(NWAVES * 64, 2) fwd_kernel(Args args) {
    extern __shared__ __attribute__((aligned(16))) unsigned char lds[];
    Frame F;
    F.lds = (LAS unsigned char*)lds;
    volatile LAS unsigned* MISC = (volatile LAS unsigned*)(F.lds + MISC_OFF);
    F.tid = threadIdx.x; F.lane = F.tid & 63; F.wave = __builtin_amdgcn_readfirstlane(F.tid >> 6); F.G = gridDim.x;
    F.out = args.out; F.ws = args.ws;
    unsigned char* ws = args.ws;
    gu32* ctl = (gu32*)(ws + WS_CTL);
    for (int u = F.tid; u < 32; u += NWAVES * 64) MISC[u] = 0u;
    __syncthreads();
    XcdBarrier bar = xcd_barrier_post((unsigned*)(ctl + CW_BAR), MISC + 8);
    const int lo = args.ph_lo, hi = args.ph_hi;
#ifndef PROBE_MASK
#define PROBE_MASK 0
#endif
#ifndef PROBE_REP
#define PROBE_REP 3
#endif
    unsigned long long pr_prev = PROBE_MASK ? rt() : 0ull, pr_acc = 0ull;
    unsigned clk_mhz = 0u;
#define PROBE_MARK(k) do { if (PROBE_MASK) { const unsigned long long _n = rt(); if (PROBE_MASK & (1 << (k))) pr_acc += _n - pr_prev; pr_prev = _n; } } while (0)
#define IN(k) (lo <= (k) && (k) < hi)
#define BOTH(k) (IN(k) && IN((k) + 1))
#define GRID_BAR() xcd_barrier(bar)
#define FIN_POST(j) do { asm volatile("s_waitcnt vmcnt(0)" ::: "memory"); __syncthreads(); if (F.tid == 0) { __builtin_amdgcn_fence(__ATOMIC_RELEASE, "agent"); asm volatile("s_waitcnt vmcnt(0)" ::: "memory"); \
        (void)xb_add((unsigned*)(ctl + CW_FIN + 64 * (j)), 1u); } } while (0)
#define FIN_GATE(S, j) do { (S).fin = (unsigned*)(ctl + CW_FIN + 64 * (j)); (S).tmo = (unsigned*)(ctl + CW_BAR + XB_TMO); } while (0)
    float* ssq = (float*)(ctl + CW_SSQ);
    typedef pg8::bf16_t pb;

    if (IN(0)) { p0_prologue(F, args); if (BOTH(0)) GRID_BAR(); PROBE_MARK(0); }

    if (IN(1)) {
        {
            pg8::Gemm g{(const pb*)(ws + WS_XB), (const pb*)(ws + WS_WIN), DM}; pg8::StaticOrder S; S.init(MTOK, IN16_N, DM, F.G, (int)blockIdx.x, WGM_A);
            pg8::EpiIn E{(pb*)(ws + WS_Q), (pb*)(ws + WS_K), (pb*)(ws + WS_V), (pb*)(ws + WS_HQ), (pb*)(ws + WS_KK), (pb*)(ws + WS_HI), (pb*)(ws + WS_OG), (pb*)(ws + WS_SA), (pb*)(ws + WS_SB),
                         (float*)(ws + WS_LG), (const float*)(ws + WS_R0), args.in[I_GQ], args.in[I_GK], args.in[I_LB], F.out, (PG8_LAS float*)(F.lds + TAB_OFF), IN16_LO / 256, 1.0f, 0};
            pg8::gemm_phase<pg8::EpiIn, pg8::StaticOrder, true, true>(F.lds + RING_OFF, g, S, E);
            {
                const int nb16 = (MTOK / 256) * (IN16_N / 256), rem16 = nb16 % F.G;
                const int nf8 = (MTOK / 256) * ((IN8_Q + IN8_G) / 256), n4 = nf8 / F.G, extra = nf8 - n4 * F.G;
                pg8::Gemm g8{(const pb*)(ws + WS_XF8), (const pb*)(ws + WS_WIN8), DM / 2}; pg8::TailOrder S8; S8.init(MTOK, IN8_Q + IN8_G, DM / 2, F.G, (int)blockIdx.x, n4, rem16, rem16 + extra, WGM_B);
                pg8::EpiIn E8 = E; E8.pn_split = IN8_Q / 256; E8.pn_off = 60 - IN8_Q / 256; E8.ascale = 0.015625f;
                pg8::gemm_phase<pg8::EpiIn, pg8::TailOrder, true, true, true>(F.lds + RING_OFF, g8, S8, E8);
            }
            if (F.G == 256 && (int)blockIdx.x >= P0_SL_LO) {
                const int c = (int)blockIdx.x, n = c < P0_SL_HI ? P0_DEF1 : P0_DEF1B,
                          base = P0_NITEMS - P0_NDEF + (c < P0_SL_HI ? (c - P0_SL_LO) * P0_DEF1 : (P0_SL_HI - P0_SL_LO) * P0_DEF1 + (c - P0_SL_HI) * P0_DEF1B);
                p0_items(F, args, base, base + n, F.wave, NWAVES);
                __syncthreads();
            }
#if defined(EXP_KLOOP) && EXP_KLOOP == 1
            { pg8::EpiNull EN; pg8::gemm_phase<pg8::EpiNull, pg8::StaticOrder, true, true>(F.lds + RING_OFF, g, S, EN); }
#endif
        }
        {
            pg8::Gemm g{(const pb*)(ws + WS_PB), (const pb*)(ws + WS_WPLE), PLED}; pg8::StaticOrder S; S.init(MTOK, DM, PLED, F.G, (int)blockIdx.x);
            pg8::EpiEw<0> E{(pb*)(ws + WS_PP), nullptr, nullptr, nullptr, nullptr, nullptr, nullptr, DM, nullptr, nullptr, 1};
            pg8::gemm_phase<pg8::EpiEw<0>, pg8::StaticOrder, true, true>(F.lds + RING_OFF, g, S, E);
        }
        if (BOTH(1)) GRID_BAR(); PROBE_MARK(1);
    }

    if (IN(2)) {
        const int spos = (int)(blockIdx.x % 3u);
        if (spos == 0) { attn_sample_phase(F, args); __syncthreads(); }
#if defined(EXP_KLOOP) && EXP_KLOOP == 5
        attn_sample_phase(F, args); __syncthreads();
#endif
#if defined(EXP_KLOOP) && EXP_KLOOP == 6
        attn_prompt_phase(F, args); __syncthreads();
#endif
#ifndef HG_PAIRS
        hgrn_pass_a(F, args);
#else
        if (F.G == 256) hgrn_pass_a2(F, args); else hgrn_pass_a(F, args);
#endif
        __syncthreads();
        if (spos == 1) { attn_sample_phase(F, args); __syncthreads(); }
        attn_prompt_phase(F, args);
        __syncthreads();
        if (spos == 2) attn_sample_phase(F, args);
        if (BOTH(2)) GRID_BAR(); PROBE_MARK(2);
    }
    if (IN(3)) {
#ifdef USE_DEF3
        if (F.G == 256) {
            p0_ptab(F, args);
            if (F.wave >= 4) { const int base = P0_NITEMS - P0_NDEF - P0_NDEF3 + (int)blockIdx.x * P0_DEF3; p0_items_run(F, base, base + P0_DEF3, F.wave - 4, 4); }
            else { hgrn_scan(F, args, 256); attn_merge_phase(F, args, 256); }
        } else
#endif
        {
        hgrn_scan(F, args);
        attn_merge_phase(F, args);
        }
        if (BOTH(3)) GRID_BAR(); PROBE_MARK(3);
    }
    if (IN(4)) {
#ifndef HG_PAIRS
        hgrn_pass_c(F, args);
#else
        if (F.G == 256) hgrn_pass_c2(F, args); else hgrn_pass_c(F, args);
#endif
#if defined(EXP_KLOOP) && EXP_KLOOP == 2
        __syncthreads();
        hgrn_pass_c(F, args);
#endif
        if (BOTH(4)) GRID_BAR(); PROBE_MARK(4);
    }

    float* part = (float*)(ws + WS_PART);
    const int gtid = (int)blockIdx.x * (NWAVES * 64) + F.tid, gthreads = F.G * NWAVES * 64;
    if (IN(5)) {
        {
            pg8::Gemm g{(const pb*)(ws + WS_OATT), (const pb*)(ws + WS_WUPA), AW}; pg8::PanelOrder S; S.init(TOKP, DM, AW, F.G, (int)blockIdx.x, 4);
            pg8::EpiEw<1> E{(pb*)(ws + WS_P1B), (const pb*)(ws + WS_SA), nullptr, nullptr, nullptr, nullptr, nullptr, DM, nullptr, part, AW / 4};
            pg8::gemm_phase<pg8::EpiEw<1>, pg8::PanelOrder, true, true>(F.lds + RING_OFF, g, S, E);
        }
        if (F.G == 256 && (int)blockIdx.x >= 64) { const int base = P0_NITEMS - P0_NDEF2 + ((int)blockIdx.x - 64) * P0_DEF2; p0_items(F, args, base, base + P0_DEF2, F.wave, NWAVES); }
        VM_WAIT(); __syncthreads();
        {
            pg8::Gemm g{(const pb*)(ws + WS_OHG), (const pb*)(ws + WS_WUPH), HGW}; pg8::PanelOrder S; S.init(TOKP, DM, HGW, F.G, (int)blockIdx.x, 8);
            pg8::EpiEw<2> E{(pb*)(ws + WS_MRG), (const pb*)(ws + WS_SB), (const pb*)(ws + WS_P1B), nullptr, nullptr, nullptr, nullptr, DM, nullptr, part + (size_t)4 * 256 * DM, HGW / 8};
            pg8::gemm_phase<pg8::EpiEw<2>, pg8::PanelOrder, true, true>(F.lds + RING_OFF, g, S, E);
        }
        if (F.G == 256 && (int)blockIdx.x >= 128) { const int base = P0_NITEMS - P0_NDEF2 + (192 + (int)blockIdx.x - 128) * P0_DEF2; p0_items(F, args, base, base + P0_DEF2, F.wave, NWAVES); __syncthreads(); }
        if (BOTH(5)) GRID_BAR(); PROBE_MARK(5);
    }
    if (IN(6)) {
        for (int it = gtid; it < 256 * (DM / 8); it += gthreads) {
            const int rs_ = it >> 9, c8 = it & 511;
            f32x4 a1 = {0.f, 0.f, 0.f, 0.f}, b1 = a1, a2 = a1, b2 = a1;
            for (int sp = 0; sp < 4; ++sp) { const float* p = part + ((size_t)sp * 256 + rs_) * DM + c8 * 8; a1 += *(const f32x4*)p; b1 += *(const f32x4*)(p + 4); }
            for (int sp = 4; sp < 12; ++sp) { const float* p = part + ((size_t)sp * 256 + rs_) * DM + c8 * 8; a2 += *(const f32x4*)p; b2 += *(const f32x4*)(p + 4); }
            const size_t off = (size_t)(TOKP + rs_) * DM + c8 * 8;
            f32x4 sa0, sa1, sb0, sb1; pg8::ld_bf16x8((const pb*)(ws + WS_SA) + off, sa0, sa1); pg8::ld_bf16x8((const pb*)(ws + WS_SB) + off, sb0, sb1);
            pg8::st_bf16x8((pb*)(ws + WS_MRG) + off, a1 * sa0 + a2 * sb0, b1 * sa1 + b2 * sb1);
        }
        if (BOTH(6)) FIN_POST(0); PROBE_MARK(6);
    }

    {
        pg8::EpiEw<3> E{(pb*)(ws + WS_X1B), (const pb*)(ws + WS_XB), nullptr, nullptr, nullptr, nullptr, ssq, DM, nullptr, part, DM / 16};
        if (IN(7)) {
            pg8::Gemm g{(const pb*)(ws + WS_MRG), (const pb*)(ws + WS_WOUT), DM}; pg8::PanelOrder S; S.init(TOKP, DM, DM, F.G, (int)blockIdx.x, 16); if (BOTH(6)) FIN_GATE(S, 0);
            pg8::gemm_phase<pg8::EpiEw<3>, pg8::PanelOrder, true, true>(F.lds + RING_OFF, g, S, E);
            if (BOTH(7)) GRID_BAR(); PROBE_MARK(7);
        }
        if (IN(8)) { E.finalize(16, gtid, gthreads); if (BOTH(8)) FIN_POST(1); PROBE_MARK(8); }
    }

    {
        pg8::EpiEw<4> E{(pb*)(ws + WS_U), nullptr, nullptr, nullptr, nullptr, nullptr, ssq, FFH, nullptr, part, DM / 4};
        if (IN(9)) {
#if defined(EXP_KLOOP) && EXP_KLOOP == 4
            const unsigned long long ck0 = __builtin_amdgcn_s_memtime(), rk0 = rt();
#endif
            pg8::Gemm g{(const pb*)(ws + WS_X1B), (const pb*)(ws + WS_WFFU), DM}; pg8::PanelOrder S; S.init(TOKP, FFH, DM, F.G, (int)blockIdx.x, 4, WGM_9); if (BOTH(8)) FIN_GATE(S, 1);
            pg8::gemm_phase<pg8::EpiEw<4>, pg8::PanelOrder, true, true>(F.lds + RING_OFF, g, S, E);
#if defined(EXP_KLOOP) && EXP_KLOOP == 3
            { pg8::EpiNull EN; pg8::gemm_phase<pg8::EpiNull, pg8::PanelOrder, true, true>(F.lds + RING_OFF, g, S, EN); }
#endif
#if defined(EXP_KLOOP) && EXP_KLOOP == 4
            { const unsigned long long ck1 = __builtin_amdgcn_s_memtime(), rk1 = rt(); clk_mhz = (unsigned)((ck1 - ck0) * 100ull / (rk1 - rk0)); }
#endif
            if (BOTH(9)) GRID_BAR(); PROBE_MARK(9);
        }
        if (IN(10)) { E.finalize(4, gtid, gthreads); if (BOTH(10)) FIN_POST(2); PROBE_MARK(10); }
    }

    {
        pg8::EpiEw<5> E{(pb*)(ws + WS_X2B), nullptr, (const pb*)(ws + WS_X1B), nullptr, nullptr, nullptr, nullptr, DM, ws + WS_X2F8, part, FFH / 16};
        if (IN(11)) {
            pg8::Gemm g{(const pb*)(ws + WS_U), (const pb*)(ws + WS_WFFD), FFH}; pg8::PanelOrder S; S.init(TOKP, DM, FFH, F.G, (int)blockIdx.x, 16, WGM_11); if (BOTH(10)) FIN_GATE(S, 2);
            pg8::gemm_phase<pg8::EpiEw<5>, pg8::PanelOrder, true, true>(F.lds + RING_OFF, g, S, E);
#if defined(EXP_KLOOP) && EXP_KLOOP == 3
            { pg8::EpiNull EN; pg8::gemm_phase<pg8::EpiNull, pg8::PanelOrder, true, true>(F.lds + RING_OFF, g, S, EN); }
#endif
            if (BOTH(11)) GRID_BAR(); PROBE_MARK(11);
        }
        if (IN(12)) { E.finalize(16, gtid, gthreads); if (BOTH(12)) FIN_POST(3); PROBE_MARK(12); }
    }

    {
        pg8::EpiEw<6> E{nullptr, (const pb*)(ws + WS_PP), (const pb*)(ws + WS_X2B), F.out, nullptr, nullptr, nullptr, DM, nullptr, part, 2048 / 8};
        if (IN(13)) {
            pg8::Gemm g{(const pb*)(ws + WS_X2F8), (const pb*)(ws + WS_WPG), DM / 2}; pg8::PanelOrder S; S.init(TOKP, DM, DM / 2, F.G, (int)blockIdx.x, 8); if (BOTH(12)) FIN_GATE(S, 3);
            pg8::gemm_phase<pg8::EpiEw<6>, pg8::PanelOrder, true, true, true>(F.lds + RING_OFF, g, S, E);
            if (BOTH(13)) GRID_BAR(); PROBE_MARK(13);
        }
        if (IN(14)) { E.finalize(8, gtid, gthreads); }
    }
    PROBE_MARK(14);
#if defined(EXP_KLOOP) && EXP_KLOOP == 4
    { const unsigned long long t0 = rt(), tgt = (unsigned long long)clk_mhz * 100ull; while (rt() - t0 < tgt) __builtin_amdgcn_s_sleep(8); }
#endif
    if (PROBE_MASK) { const unsigned long long t0 = rt(), tgt = pr_acc * PROBE_REP; while (rt() - t0 < tgt) __builtin_amdgcn_s_sleep(8); }
#undef IN
#undef BOTH
#undef GRID_BAR
}

#ifndef MK_PER_PHASE
#define MK_PER_PHASE 0
#endif
extern "C" void kernel_launch(void* const* d_in, const int* in_sizes, int n_in, void* d_out, int out_size, void* d_ws, size_t ws_size, hipStream_t stream) {
    static int grid = 0;
    if (grid == 0) {
        if (n_in != 22 || out_size != (int)pg8::O_TOTAL || ws_size < WS_END) { fprintf(stderr, "kernel_launch: unexpected shapes (n_in %d out %d ws %zu need %zu)\n", n_in, out_size, ws_size, (size_t)WS_END); grid = -1; return; }
        int dev = 0, cus = 0, per_cu = 0;
        if (hipGetDevice(&dev) != hipSuccess || hipDeviceGetAttribute(&cus, hipDeviceAttributeMultiprocessorCount, dev) != hipSuccess) { grid = -1; return; }
        if (hipFuncSetAttribute((const void*)fwd_kernel, hipFuncAttributeMaxDynamicSharedMemorySize, LDS_BYTES) != hipSuccess) { grid = -1; return; }
        if (hipOccupancyMaxActiveBlocksPerMultiprocessor(&per_cu, (const void*)fwd_kernel, NWAVES * 64, LDS_BYTES) != hipSuccess || per_cu < 1) { fprintf(stderr, "kernel_launch: occupancy query says %d\n", per_cu); }
        (void)hipGetLastError();
        grid = cus;
    }
    if (grid < 0) return;
    if (hipMemsetAsync((char*)d_ws + WS_CTL, 0, CTL_ZERO_BYTES, stream) != hipSuccess) return;
    Args a;
    memset(&a, 0, sizeof(a));
    for (int i = 0; i < 22; ++i) a.in[i] = (const float*)d_in[i];
    a.out = (float*)d_out; a.ws = (unsigned char*)d_ws;
#if MK_PER_PHASE
    for (int p = 0; p < 15; ++p) { a.ph_lo = p; a.ph_hi = p + 1; hipLaunchKernelGGL(fwd_kernel, dim3(grid), dim3(NWAVES * 64), LDS_BYTES, stream, a); }
#else
    a.ph_lo = 0; a.ph_hi = 15;
    hipLaunchKernelGGL(fwd_kernel, dim3(grid), dim3(NWAVES * 64), LDS_BYTES, stream, a);
#endif
}
```
